# Optimizing an MI355X kernel written in HIP

```python
import math
import jax, jax.numpy as jnp
from jax import lax
import numpy as np

D_MODEL = 1024
BATCH = 8
SEQ = 4096
DEPTH = 2

CHUNK = 64
N_EVEN = (DEPTH + 1) // 2
N_ODD = DEPTH // 2
N_SUB = 3
D_FF = ((8 * D_MODEL // 3 + 127) // 128) * 128
RMS_EPS = 1e-6

GM_BLOCK = 128
GM_WIDTH = D_MODEL
GM_GROUPS = 8
GM_GROUP_DIM = GM_WIDTH // GM_GROUPS

SSD_WIDTH = D_MODEL
SSD_HEAD_DIM = 64
SSD_HEADS = SSD_WIDTH // SSD_HEAD_DIM
SSD_GROUPS = 2
SSD_STATE = 128
SSD_CONV = 4
SSD_CHUNK = CHUNK
SSD_CONV_DIM = SSD_WIDTH + 2 * SSD_GROUPS * SSD_STATE

IN_WIDTH = 2 * GM_WIDTH + SSD_WIDTH + SSD_CONV_DIM + SSD_HEADS
MIX_WIDTH = GM_WIDTH + SSD_WIDTH

SB_WIDTH = D_MODEL
SB_HEAD_DIM = 64
SB_HEADS = SB_WIDTH // SB_HEAD_DIM
SB_BLOCK = 128

kernel_name = "hybrid_gmlp_ssd_stickbreaking_macaron_adaln"


def rms_norm(x, g):
    xf = x.astype(jnp.float32)
    y = xf * lax.rsqrt(jnp.mean(xf * xf, axis=-1, keepdims=True) + RMS_EPS)
    return (y * g.astype(jnp.float32)).astype(x.dtype)


def modulate(h, shift, scale):
    return h * (1 + scale[:, None, :]) + shift[:, None, :]


def swiglu(h, w_gate, w_up, w_down):
    return (jax.nn.silu(h @ w_gate) * (h @ w_up)) @ w_down


def chunked_gmlp(u, v, v_norm_g, w_s, b_s):
    b, s, _ = u.shape
    nc = s // GM_BLOCK
    v = v.reshape(b, nc, GM_BLOCK, GM_GROUPS, GM_GROUP_DIM)
    v = rms_norm(v, v_norm_g.reshape(GM_GROUPS, GM_GROUP_DIM))
    pos = np.arange(GM_BLOCK)
    mask = (pos[None, :] // CHUNK) <= (pos[:, None] // CHUNK)
    w = w_s * jnp.asarray(mask, dtype=w_s.dtype)[None]
    mixed = jnp.einsum('gts,bnsgc->bntgc', w, v) + b_s.T[:, :, None]
    return u * mixed.reshape(b, s, GM_WIDTH)


def causal_dwconv(x, w, bias):
    k = w.shape[0]
    s = x.shape[1]
    xp = jnp.pad(x, ((0, 0), (k - 1, 0), (0, 0)))
    return sum(xp[:, i:i + s] * w[i] for i in range(k)) + bias


def ssd_mixer(z, xbc, dt_raw, conv_w, conv_b, dt_bias, a_log, d_skip, norm_g):
    b, s, _ = z.shape
    nc = s // SSD_CHUNK
    e = SSD_HEADS // SSD_GROUPS
    xbc = jax.nn.silu(causal_dwconv(xbc, conv_w, conv_b))
    xs, bm, cm = jnp.split(xbc, [SSD_WIDTH, SSD_WIDTH + SSD_GROUPS * SSD_STATE], axis=-1)
    xs = xs.reshape(b, nc, SSD_CHUNK, SSD_GROUPS, e, SSD_HEAD_DIM)
    bm = bm.reshape(b, nc, SSD_CHUNK, SSD_GROUPS, SSD_STATE)
    cm = cm.reshape(b, nc, SSD_CHUNK, SSD_GROUPS, SSD_STATE)
    dt = jax.nn.softplus((dt_raw + dt_bias).astype(jnp.float32))
    dt = dt.reshape(b, nc, SSD_CHUNK, SSD_GROUPS, e)
    a = -jnp.exp(a_log.astype(jnp.float32)).reshape(SSD_GROUPS, e)
    cs = jnp.cumsum(dt * a, axis=2)
    seg = cs[:, :, :, None] - cs[:, :, None, :]
    pos = np.arange(SSD_CHUNK)
    causal = (pos[:, None] >= pos[None, :])[None, None, :, :, None, None]
    decay = jnp.exp(jnp.where(causal, seg, -jnp.inf))
    cb = jnp.einsum('bctgn,bcsgn->bctsg', cm, bm)
    w_ts = (cb[..., None] * decay * dt[:, :, None]).astype(xs.dtype)
    y_diag = jnp.einsum('bctsge,bcsgep->bctgep', w_ts, xs)
    decay_to_end = (jnp.exp(cs[:, :, -1:] - cs) * dt).astype(xs.dtype)
    states = jnp.einsum('bclgn,bclge,bclgep->bcgepn', bm, decay_to_end, xs)
    chunk_decay = jnp.exp(cs[:, :, -1]).astype(xs.dtype)

    def step(h, inp):
        st, dec = inp
        return h * dec[..., None, None] + st, h

    h0 = jnp.zeros_like(states[:, 0])
    _, h_in = lax.scan(step, h0, (jnp.moveaxis(states, 1, 0), jnp.moveaxis(chunk_decay, 1, 0)))
    h_in = jnp.moveaxis(h_in, 0, 1)
    y_off = jnp.einsum('bctgn,bcgepn->bctgep', cm, h_in) * jnp.exp(cs).astype(xs.dtype)[..., None]
    y = y_diag + y_off + d_skip.reshape(SSD_GROUPS, e)[:, :, None] * xs
    y = y.reshape(b, s, SSD_WIDTH)
    return rms_norm(y * jax.nn.silu(z), norm_g)


def hybrid_mixer(h, w_in, w_out, v_norm_g, w_s, b_s, conv_w, conv_b, dt_bias, a_log, d_skip, ssd_norm_g):
    proj = h @ w_in
    o1 = 2 * GM_WIDTH
    o2 = o1 + SSD_WIDTH
    o3 = o2 + SSD_CONV_DIM
    gm_part, z, xbc, dt_raw = jnp.split(proj, [o1, o2, o3], axis=-1)
    u, v = jnp.split(jax.nn.gelu(gm_part), 2, axis=-1)
    y_a = chunked_gmlp(u, v, v_norm_g, w_s, b_s)
    y_b = ssd_mixer(z, xbc, dt_raw, conv_w, conv_b, dt_bias, a_log, d_skip, ssd_norm_g)
    return jnp.concatenate([y_a, y_b], axis=-1) @ w_out


def stick_breaking_attention(q, k, v):
    b, nh, s, d = q.shape
    scale = d ** -0.5
    outs = []
    for i in range(s // SB_BLOCK):
        q0 = i * SB_BLOCK
        kv_len = q0 + SB_BLOCK
        qb = q[:, :, q0:kv_len]
        kb = k[:, :, :kv_len]
        vb = v[:, :, :kv_len]
        logits = jnp.einsum('bhtd,bhsd->bhts', qb, kb).astype(jnp.float32) * scale
        t_idx = q0 + np.arange(SB_BLOCK)[:, None]
        s_idx = np.arange(kv_len)[None, :]
        strict = jnp.asarray(s_idx < t_idx)
        log_beta = jax.nn.log_sigmoid(logits)
        log_keep = jnp.where(strict, jax.nn.log_sigmoid(-logits), 0.0)
        after = lax.cumsum(log_keep, axis=3, reverse=True) - log_keep
        wgt = jnp.where(strict, jnp.exp(log_beta + after), 0.0)
        outs.append(jnp.einsum('bhts,bhsd->bhtd', wgt.astype(vb.dtype), vb))
    return jnp.concatenate(outs, axis=2)


def sb_mixer(h, w_qkv, q_norm_g, k_norm_g, w_o):
    b, s, _ = h.shape
    qkv = (h @ w_qkv).reshape(b, s, 3, SB_HEADS, SB_HEAD_DIM)
    q = rms_norm(qkv[:, :, 0], q_norm_g).transpose(0, 2, 1, 3)
    k = rms_norm(qkv[:, :, 1], k_norm_g).transpose(0, 2, 1, 3)
    v = qkv[:, :, 2].transpose(0, 2, 1, 3)
    o = stick_breaking_attention(q, k, v)
    return o.transpose(0, 2, 1, 3).reshape(b, s, SB_WIDTH) @ w_o


def setup_inputs(seed: int = 0) -> dict:
    key = jax.random.key(seed)
    ks = iter(jax.random.split(key, 32))

    def nrm(shape, scale):
        return jax.random.normal(next(ks), shape, jnp.float32) * scale

    d = D_MODEL
    dt0 = jnp.exp(jax.random.uniform(next(ks), (N_EVEN, SSD_HEADS), jnp.float32,
                                     minval=math.log(1e-3), maxval=math.log(1e-1)))
    return {
        "x": nrm((BATCH, SEQ, d), 1.0),
        "c": nrm((BATCH, d), 1.0),
        "mod_w": nrm((DEPTH, d, N_SUB * 3 * d), 0.5 * d ** -0.5),
        "mod_b": nrm((DEPTH, N_SUB * 3 * d), 0.01),
        "norm_g": 1.0 + nrm((DEPTH, 4, d), 0.02),
        "ffn_w_gate": nrm((DEPTH, 2, d, D_FF), d ** -0.5),
        "ffn_w_up": nrm((DEPTH, 2, d, D_FF), d ** -0.5),
        "ffn_w_down": nrm((DEPTH, 2, D_FF, d), D_FF ** -0.5),
        "hy_w_in": nrm((N_EVEN, d, IN_WIDTH), d ** -0.5),
        "hy_w_out": nrm((N_EVEN, MIX_WIDTH, d), MIX_WIDTH ** -0.5),
        "gm_v_norm_g": 1.0 + nrm((N_EVEN, GM_WIDTH), 0.02),
        "gm_w_s": nrm((N_EVEN, GM_GROUPS, GM_BLOCK, GM_BLOCK), GM_BLOCK ** -0.5),
        "gm_b_s": 1.0 + nrm((N_EVEN, GM_GROUPS, GM_BLOCK), 0.02),
        "ssd_conv_w": nrm((N_EVEN, SSD_CONV, SSD_CONV_DIM), SSD_CONV ** -0.5),
        "ssd_conv_b": nrm((N_EVEN, SSD_CONV_DIM), 0.01),
        "ssd_dt_bias": dt0 + jnp.log(-jnp.expm1(-dt0)),
        "ssd_a_log": jnp.log(jax.random.uniform(next(ks), (N_EVEN, SSD_HEADS), jnp.float32,
                                                 minval=1.0, maxval=16.0)),
        "ssd_d": 1.0 + nrm((N_EVEN, SSD_HEADS), 0.1),
        "ssd_norm_g": 1.0 + nrm((N_EVEN, SSD_WIDTH), 0.02),
        "sb_w_qkv": nrm((N_ODD, d, 3 * SB_WIDTH), d ** -0.5),
        "sb_q_norm_g": 1.0 + nrm((N_ODD, SB_HEAD_DIM), 0.02),
        "sb_k_norm_g": 1.0 + nrm((N_ODD, SB_HEAD_DIM), 0.02),
        "sb_w_o": nrm((N_ODD, SB_WIDTH, d), SB_WIDTH ** -0.5),
    }


def reference(x, c, mod_w, mod_b, norm_g, ffn_w_gate, ffn_w_up, ffn_w_down,
              hy_w_in, hy_w_out, gm_v_norm_g, gm_w_s, gm_b_s,
              ssd_conv_w, ssd_conv_b, ssd_dt_bias, ssd_a_log, ssd_d, ssd_norm_g,
              sb_w_qkv, sb_q_norm_g, sb_k_norm_g, sb_w_o):
    cond = jax.nn.silu(c)
    h = x
    for layer in range(DEPTH):
        mod = (cond @ mod_w[layer] + mod_b[layer]).reshape(-1, N_SUB, 3, D_MODEL)
        y = modulate(rms_norm(h, norm_g[layer, 0]), mod[:, 0, 0], mod[:, 0, 1])
        h = h + 0.5 * mod[:, 0, 2][:, None] * swiglu(
            y, ffn_w_gate[layer, 0], ffn_w_up[layer, 0], ffn_w_down[layer, 0])
        y = modulate(rms_norm(h, norm_g[layer, 1]), mod[:, 1, 0], mod[:, 1, 1])
        j = layer // 2
        if layer % 2 == 0:
            mix = hybrid_mixer(y, hy_w_in[j], hy_w_out[j], gm_v_norm_g[j], gm_w_s[j], gm_b_s[j],
                               ssd_conv_w[j], ssd_conv_b[j], ssd_dt_bias[j], ssd_a_log[j],
                               ssd_d[j], ssd_norm_g[j])
        else:
            mix = sb_mixer(y, sb_w_qkv[j], sb_q_norm_g[j], sb_k_norm_g[j], sb_w_o[j])
        h = h + mod[:, 1, 2][:, None] * mix
        y = modulate(rms_norm(h, norm_g[layer, 2]), mod[:, 2, 0], mod[:, 2, 1])
        h = h + 0.5 * mod[:, 2, 2][:, None] * swiglu(
            y, ffn_w_gate[layer, 1], ffn_w_up[layer, 1], ffn_w_down[layer, 1])
        h = rms_norm(h, norm_g[layer, 3])
    return h
```

```cpp
#include <hip/hip_runtime.h>
#include <hip/hip_cooperative_groups.h>
#include <cstdio>
#include <cstdint>
namespace cg = cooperative_groups;

#define DI __device__ __forceinline__
#define LAS __attribute__((address_space(3)))
typedef unsigned short bf16_t;
typedef short bf16x8 __attribute__((ext_vector_type(8)));
typedef float f32x4 __attribute__((ext_vector_type(4)));
typedef float f32x16 __attribute__((ext_vector_type(16)));
typedef unsigned u32x4 __attribute__((ext_vector_type(4)));
typedef unsigned u32x2 __attribute__((ext_vector_type(2)));

constexpr int T = 32768, D = 1024, FF = 2816, SEQ = 4096, NB = 8;
constexpr int INW = 4624, PW = 4608;
constexpr int MODW = 9216;
constexpr float EPS = 1e-6f;
constexpr float LOG2E = 1.4426950408889634f, LN2 = 0.6931471805599453f;
constexpr int NTHREADS = 512, NWAVES = 8;
constexpr int LDS_BYTES = 147456;

constexpr size_t MiB = 1u << 20;
constexpr size_t WS_MOD = 0;
constexpr size_t WS_ROWSS = 1 * MiB;
constexpr size_t WS_DT = 2 * MiB;
constexpr size_t WS_WGU = 4 * MiB;
constexpr size_t WS_WDN = 48 * MiB;
constexpr size_t WS_WIN = 70 * MiB;
constexpr size_t WS_WOUT1 = 79 * MiB, WS_WOUT2 = 81 * MiB;
constexpr size_t WS_WQK = 83 * MiB;
constexpr size_t WS_WV = 87 * MiB, WS_WO = 89 * MiB;
constexpr size_t WS_XN = 92 * MiB;
constexpr size_t WS_BIG = 156 * MiB;
constexpr size_t WS_Q = WS_BIG, WS_K = WS_BIG + 64 * MiB, WS_VT = WS_BIG + 128 * MiB;
constexpr size_t WS_END = 444 * MiB;

DI unsigned f2bf(float f) { unsigned u = __builtin_bit_cast(unsigned, f); return (u + 0x7fffu + ((u >> 16) & 1u)) >> 16; }
typedef float f32x2_t __attribute__((ext_vector_type(2))); typedef __bf16 bf16x2_t __attribute__((ext_vector_type(2)));
DI unsigned cvt_pk_bf16(float lo, float hi) { f32x2_t v = {lo, hi}; bf16x2_t b = __builtin_convertvector(v, bf16x2_t); return __builtin_bit_cast(unsigned, b); }
DI unsigned pk2(float lo, float hi) { return cvt_pk_bf16(lo, hi); }
DI float bflo(unsigned u) { return __uint_as_float(u << 16); }
DI float bfhi(unsigned u) { return __uint_as_float(u & 0xffff0000u); }
DI float ex2(float x) { return __builtin_amdgcn_exp2f(x); }
DI float lg2(float x) { return __builtin_amdgcn_logf(x); }
DI float rcpf_(float x) { return __builtin_amdgcn_rcpf(x); }
DI float silu_f(float x) { return x * rcpf_(1.f + ex2(-x * LOG2E)); }
DI float gelu_tanh_f(float x) { const float u = 0.7978845608028654f * (x + 0.044715f * x * x * x); return x * rcpf_(1.f + ex2(-2.f * LOG2E * u)); }
DI float softplus_f(float x) { return fmaxf(x, 0.f) + LN2 * lg2(1.f + ex2(-fabsf(x) * LOG2E)); }
DI float wave_sum(float v) {
#pragma unroll
    for (int o = 1; o < 64; o <<= 1) v += __shfl_xor(v, o);
    return v;
}

namespace pg8 {
constexpr int BM = 256, BK = 64, HALF = 128, HTB = HALF * BK * 2, STAGE_BYTES = 8 * HTB, NXCD = 8, WGM = 8;
DI int lds_byte(int r, int c) { const int st = (r >> 4) * 2 + (c >> 5), rr = r & 15, cc = c & 31, ob = rr * 64 + cc * 2; return st * 1024 + (ob ^ (((ob >> 9) & 1) << 5)); }
DI void stage_rc(int b, int& R, int& C) { const int st = b / 1024, sb = b % 1024, swz = sb ^ (((sb >> 9) & 1) << 5); R = (st >> 1) * 16 + swz / 64; C = (st & 1) * 32 + (swz % 64) / 2; }
DI int perm32(int rho) { const int n = rho >> 4, i = rho & 15; return 8 * (i >> 2) + 4 * n + (i & 3); }

struct Unit { int pm, pn; };
struct Gemm { const bf16_t* A; const bf16_t* Bt; int M, N, K, lda; };

struct StaticOrder {
    int nM, nN, nwg, G, c;
    DI void init(int M, int N, int G_, int c_) { nM = M / BM; nN = N / BM; nwg = nM * nN; G = G_; c = c_; }
    DI bool next(int i, Unit& u) const {
        const long L = (long)i * G + c; if (L >= nwg) return false;
        int wgid = (int)L; { const int q = nwg / NXCD, r = nwg % NXCD, xcd = wgid % NXCD, off = wgid / NXCD; wgid = (xcd < r ? xcd * (q + 1) : r * (q + 1) + (xcd - r) * q) + off; }
        const int nig = WGM * nN, gid = wgid / nig, fm = gid * WGM, gsz = (nM - fm) < WGM ? (nM - fm) : WGM;
        u.pm = fm + ((wgid % nig) % gsz); u.pn = (wgid % nig) / gsz; return true;
    }
};

template <class Epi>
DI void gemm_phase(LAS unsigned char* lds, const Gemm g, const StaticOrder& S, const Epi& E) {
    int tid_ = threadIdx.x; asm volatile("" : "+v"(tid_));
    const int tid = tid_, wid = __builtin_amdgcn_readfirstlane(tid >> 6), lane = tid & 63, wr = wid >> 2, wc = wid & 3, fr = lane & 15, fq = lane >> 4;
    const int K = g.K, nt = K / BK, lda = g.lda;
    unsigned voffA[2], voffB[2];
#pragma unroll
    for (int i = 0; i < 2; ++i) { int R, C; stage_rc(tid * 16 + i * 8192, R, C); const int Rb = (R & ~31) + perm32(R & 31);
        voffA[i] = (unsigned)(R * lda + C) * 2u; voffB[i] = (unsigned)(Rb * K + C) * 2u; }
    const size_t kstep = (size_t)(BK * 2);
    const size_t hstepA = (size_t)HALF * lda * 2, hstepB = (size_t)HALF * K * 2;
    const size_t tstepA = 2 * hstepA, tstepB = 2 * hstepB;
    const unsigned ldsw = (unsigned)wid * 1024u;
    const int aoff = lds_byte(wr * 64 + fr, fq * 8), boff = lds_byte(wc * 32 + fr, fq * 8);
#define PG8_SA(b, h) (((b) * 2 + (h)) * HTB)
#define PG8_SB(b, h) ((4 + (b) * 2 + (h)) * HTB)
#define PG8_STAGE(bufoff, gbase, voff) do { _Pragma("unroll") for (int _i = 0; _i < 2; ++_i) \
        __builtin_amdgcn_global_load_lds((const unsigned*)((const char*)(gbase) + (voff)[_i]), (LAS unsigned*)(lds + (bufoff) + ldsw + _i * 8192), 16, 0, 0); } while (0)
#define PG8_LDA(dst, b, h) do { _Pragma("unroll") for (int m = 0; m < 4; ++m) _Pragma("unroll") for (int k = 0; k < 2; ++k) dst[m][k] = *(const LAS bf16x8*)(lds + PG8_SA(b, h) + aoff + m * 2048 + k * 1024); } while (0)
#define PG8_LDB(dst, b, h) do { _Pragma("unroll") for (int n = 0; n < 2; ++n) _Pragma("unroll") for (int k = 0; k < 2; ++k) dst[n][k] = *(const LAS bf16x8*)(lds + PG8_SB(b, h) + boff + n * 2048 + k * 1024); } while (0)
#define PG8_MMA(ai, bj, At, Bt) do { __builtin_amdgcn_s_setprio(1); _Pragma("unroll") for (int m = 0; m < 4; ++m) _Pragma("unroll") for (int n = 0; n < 2; ++n) _Pragma("unroll") for (int k = 0; k < 2; ++k) \
        acc[ai][bj][m][n] = __builtin_amdgcn_mfma_f32_16x16x32_bf16(Bt[n][k], At[m][k], acc[ai][bj][m][n], 0, 0, 0); __builtin_amdgcn_s_setprio(0); } while (0)
#define PG8_WAIT_V(n) asm volatile("s_waitcnt vmcnt(" #n ")" ::: "memory")
#define PG8_WAIT_L(n) asm volatile("s_waitcnt lgkmcnt(" #n ")" ::: "memory")
#define PG8_BAR __builtin_amdgcn_s_barrier()
#define PG8_SCHED __builtin_amdgcn_sched_barrier(0)
    Unit cur, nxt; int ui = 0;
    if (!S.next(0, cur)) return;
    f32x4 acc[2][2][4][2];
#pragma unroll
    for (int a = 0; a < 2; ++a)
#pragma unroll
        for (int b = 0; b < 2; ++b)
#pragma unroll
            for (int m = 0; m < 4; ++m)
#pragma unroll
                for (int n = 0; n < 2; ++n) acc[a][b][m][n] = (f32x4){0.f, 0.f, 0.f, 0.f};
    bf16x8 At[4][2], B0[2][2], B1[2][2];
    const char* cA = (const char*)g.A + (size_t)cur.pm * tstepA; const char* cB = (const char*)g.Bt + (size_t)cur.pn * tstepB;
    PG8_STAGE(PG8_SB(0, 0), cB, voffB); PG8_STAGE(PG8_SB(0, 1), cB + hstepB, voffB); PG8_STAGE(PG8_SA(0, 0), cA, voffA); PG8_STAGE(PG8_SA(0, 1), cA + hstepA, voffA);
    if (wr == 1) PG8_BAR;
    PG8_WAIT_V(2); PG8_BAR;
    PG8_STAGE(PG8_SB(1, 0), cB + kstep, voffB); PG8_STAGE(PG8_SA(1, 0), cA + kstep, voffA); PG8_STAGE(PG8_SB(1, 1), cB + hstepB + kstep, voffB);
    PG8_WAIT_V(6); PG8_BAR;
    for (;;) {
        const bool has_next = S.next(ui + 1, nxt);
        const char* nA = has_next ? (const char*)g.A + (size_t)nxt.pm * tstepA : cA; const char* nB = has_next ? (const char*)g.Bt + (size_t)nxt.pn * tstepB : cB;
        for (int t = 0; t < nt; t += 2) {
            const bool last = (t == nt - 2);
            const char* a1 = cA + (size_t)(t + 1) * kstep;
            const char* a2 = last ? nA : cA + (size_t)(t + 2) * kstep; const char* b2 = last ? nB : cB + (size_t)(t + 2) * kstep;
            const char* a3 = a2 + kstep; const char* b3 = b2 + kstep;
            PG8_LDB(B0, 0, 0); PG8_LDB(B1, 0, 1); PG8_SCHED; PG8_LDA(At, 0, 0); PG8_STAGE(PG8_SA(1, 1), a1 + hstepA, voffA);
            PG8_WAIT_V(8); PG8_WAIT_L(0); PG8_BAR; PG8_MMA(0, 0, At, B0); PG8_MMA(0, 1, At, B1); PG8_BAR; PG8_SCHED;
            PG8_LDA(At, 0, 1); PG8_STAGE(PG8_SB(0, 0), b2, voffB); PG8_STAGE(PG8_SB(0, 1), b2 + hstepB, voffB); PG8_STAGE(PG8_SA(0, 0), a2, voffA);
            PG8_WAIT_V(8); PG8_WAIT_L(0); PG8_BAR; PG8_MMA(1, 0, At, B0); PG8_MMA(1, 1, At, B1); PG8_BAR; PG8_SCHED;
            PG8_LDB(B0, 1, 0); PG8_LDB(B1, 1, 1); PG8_SCHED; PG8_LDA(At, 1, 0); PG8_STAGE(PG8_SA(0, 1), a2 + hstepA, voffA);
            PG8_WAIT_V(8); PG8_WAIT_L(0); PG8_BAR; PG8_MMA(0, 0, At, B0); PG8_MMA(0, 1, At, B1); PG8_BAR; PG8_SCHED;
            PG8_LDA(At, 1, 1); PG8_STAGE(PG8_SB(1, 0), b3, voffB); PG8_STAGE(PG8_SB(1, 1), b3 + hstepB, voffB); PG8_STAGE(PG8_SA(1, 0), a3, voffA);
            PG8_WAIT_V(8); PG8_WAIT_L(0); PG8_BAR; PG8_MMA(1, 0, At, B0); PG8_MMA(1, 1, At, B1); PG8_BAR; PG8_SCHED;
        }
        if (wr == 0) PG8_BAR;
        E(acc, cur, wr, wc, fr, fq);
        if (!has_next) break;
#pragma unroll
        for (int a = 0; a < 2; ++a)
#pragma unroll
            for (int b = 0; b < 2; ++b)
#pragma unroll
                for (int m = 0; m < 4; ++m)
#pragma unroll
                    for (int n = 0; n < 2; ++n) acc[a][b][m][n] = (f32x4){0.f, 0.f, 0.f, 0.f};
        cur = nxt; cA = nA; cB = nB; ++ui;
        if (wr == 1) PG8_BAR;
    }
    PG8_WAIT_V(0);
    PG8_BAR;
#undef PG8_SA
#undef PG8_SB
#undef PG8_STAGE
#undef PG8_LDA
#undef PG8_LDB
#undef PG8_MMA
#undef PG8_WAIT_V
#undef PG8_WAIT_L
#undef PG8_BAR
#undef PG8_SCHED
}

typedef f32x4 Acc[2][2][4][2];

struct EpiSwiGLU {
    bf16_t* O;
    DI void operator()(const Acc& acc, const Unit& u, int wr, int wc, int fr, int fq) const {
        const int row0 = u.pm * BM + wr * 64 + fr, col0 = u.pn * 128 + wc * 32 + 8 * fq;
#pragma unroll
        for (int ai = 0; ai < 2; ++ai)
#pragma unroll
            for (int m = 0; m < 4; ++m) {
                bf16_t* rowp = O + (size_t)(row0 + ai * HALF + m * 16) * FF + col0;
                const f32x4 g0 = acc[ai][0][m][0], g1 = acc[ai][0][m][1], u0 = acc[ai][1][m][0], u1 = acc[ai][1][m][1];
                u32x4 w;
                w.x = cvt_pk_bf16(silu_f(g0[0]) * u0[0], silu_f(g0[1]) * u0[1]); w.y = cvt_pk_bf16(silu_f(g0[2]) * u0[2], silu_f(g0[3]) * u0[3]);
                w.z = cvt_pk_bf16(silu_f(g1[0]) * u1[0], silu_f(g1[1]) * u1[1]); w.w = cvt_pk_bf16(silu_f(g1[2]) * u1[2], silu_f(g1[3]) * u1[3]);
                *(u32x4*)rowp = w;
            }
    }
};
template <int CS2, bool RS> struct EpiResid {
    const float* base; float* out; const float* gate; const float* rowss;
    DI void operator()(const Acc& acc, const Unit& u, int wr, int wc, int fr, int fq) const {
        const float* const base = this->base; float* const out = this->out; const float* const gate = this->gate; const float cscale = 0.5f * CS2; const float* const rowss = this->rowss;
        const int b = (u.pm * BM) >> 12;
        const int row0 = u.pm * BM + wr * 64 + fr, col0 = u.pn * BM + wc * 32 + 8 * fq;
        f32x4 gv[2][2];
#pragma unroll
        for (int bj = 0; bj < 2; ++bj)
#pragma unroll
            for (int n = 0; n < 2; ++n) gv[bj][n] = *(const f32x4*)(gate + (size_t)b * MODW + col0 + bj * HALF + 4 * n) * cscale;
#pragma unroll
        for (int ai = 0; ai < 2; ++ai)
#pragma unroll
            for (int m = 0; m < 4; ++m) {
                const int row = row0 + ai * HALF + m * 16;
                float rs = 1.f; if (RS) rs = rsqrtf(rowss[row] * (1.f / 1024.f) + EPS);
                const size_t off = (size_t)row * D + col0;
#pragma unroll
                for (int bj = 0; bj < 2; ++bj)
#pragma unroll
                    for (int n = 0; n < 2; ++n) { const f32x4 bs = *(const f32x4*)(base + off + bj * HALF + 4 * n);
                        *(f32x4*)(out + off + bj * HALF + 4 * n) = bs + gv[bj][n] * rs * acc[ai][bj][m][n]; }
                if (m & 1) asm volatile("" ::: "memory");
            }
    }
};
struct EpiProj {
    bf16_t* O;
    DI void operator()(const Acc& acc, const Unit& u, int wr, int wc, int fr, int fq) const {
        const int row0 = u.pm * BM + wr * 64 + fr, col0 = u.pn * BM + wc * 32 + 8 * fq;
        const bool act = u.pn < 8;
#pragma unroll
        for (int ai = 0; ai < 2; ++ai)
#pragma unroll
            for (int m = 0; m < 4; ++m) {
                bf16_t* rowp = O + (size_t)(row0 + ai * HALF + m * 16) * PW + col0;
#pragma unroll
                for (int bj = 0; bj < 2; ++bj) { f32x4 v0 = acc[ai][bj][m][0], v1 = acc[ai][bj][m][1];
                    if (act) {
#pragma unroll
                        for (int i = 0; i < 4; ++i) { v0[i] = gelu_tanh_f(v0[i]); v1[i] = gelu_tanh_f(v1[i]); } }
                    u32x4 w; w.x = cvt_pk_bf16(v0[0], v0[1]); w.y = cvt_pk_bf16(v0[2], v0[3]); w.z = cvt_pk_bf16(v1[0], v1[1]); w.w = cvt_pk_bf16(v1[2], v1[3]);
                    *(u32x4*)(rowp + bj * HALF) = w; }
            }
    }
};
struct EpiQK {
    bf16_t* Q; bf16_t* Kd; const float* qg; const float* kg; float qscale;
    DI void operator()(const Acc& acc, const Unit& u, int wr, int wc, int fr, int fq) const {
        const bool isq = u.pn < 4; const int hd = (4 * u.pn + wc) & 15;
        bf16_t* dst = isq ? Q : Kd; const float* gn = isq ? qg : kg; const float sc = isq ? qscale : 1.f;
        const int row0 = u.pm * BM + wr * 64 + fr;
#pragma unroll
        for (int ai = 0; ai < 2; ++ai)
#pragma unroll
            for (int m = 0; m < 4; ++m) {
                float ss = 0.f;
#pragma unroll
                for (int bj = 0; bj < 2; ++bj)
#pragma unroll
                    for (int n = 0; n < 2; ++n) { const f32x4 x = acc[ai][bj][m][n]; ss += (x[0] * x[0] + x[1] * x[1]) + (x[2] * x[2] + x[3] * x[3]); }
                ss += __shfl_xor(ss, 16); ss += __shfl_xor(ss, 32);
                const float rstd = rsqrtf(ss * (1.f / 64.f) + EPS);
                bf16_t* rowp = dst + (size_t)(row0 + ai * HALF + m * 16) * D + hd * 64 + 8 * fq;
#pragma unroll
                for (int bj = 0; bj < 2; ++bj) { const float rs2 = rstd * sc; const f32x4 v0 = acc[ai][bj][m][0] * rs2 * *(const f32x4*)(gn + 32 * bj + 8 * fq), v1 = acc[ai][bj][m][1] * rs2 * *(const f32x4*)(gn + 32 * bj + 8 * fq + 4);
                    u32x4 w; w.x = cvt_pk_bf16(v0[0], v0[1]); w.y = cvt_pk_bf16(v0[2], v0[3]); w.z = cvt_pk_bf16(v1[0], v1[1]); w.w = cvt_pk_bf16(v1[2], v1[3]);
                    *(u32x4*)(rowp + 32 * bj) = w; }
            }
    }
};
struct EpiPlain {
    bf16_t* O; int ldc;
    DI void operator()(const Acc& acc, const Unit& u, int wr, int wc, int fr, int fq) const {
        const int row0 = u.pm * BM + wr * 64 + fr, col0 = u.pn * BM + wc * 32 + 8 * fq;
#pragma unroll
        for (int ai = 0; ai < 2; ++ai)
#pragma unroll
            for (int m = 0; m < 4; ++m) {
                bf16_t* rowp = O + (size_t)(row0 + ai * HALF + m * 16) * ldc + col0;
#pragma unroll
                for (int bj = 0; bj < 2; ++bj) { const f32x4 v0 = acc[ai][bj][m][0], v1 = acc[ai][bj][m][1];
                    u32x4 w; w.x = cvt_pk_bf16(v0[0], v0[1]); w.y = cvt_pk_bf16(v0[2], v0[3]); w.z = cvt_pk_bf16(v1[0], v1[1]); w.w = cvt_pk_bf16(v1[2], v1[3]);
                    *(u32x4*)(rowp + bj * HALF) = w; }
            }
    }
};
}

struct TDesc { const float* src; int ld; int K; int N; bf16_t* dst; int ldt; int map; int rowadd; const float* kscale; };
DI void transpose_item(const TDesc& d, int k0, int n0, int drow, LAS float* scr, int lane) {
#pragma unroll 8
    for (int i = 0; i < 32; ++i) { const int kk = 2 * i + (lane >> 5); float v = d.src[(size_t)(k0 + kk) * d.ld + n0 + (lane & 31)]; if (d.kscale) v *= d.kscale[k0 + kk]; scr[kk * 33 + (lane & 31)] = v; }
    asm volatile("s_waitcnt lgkmcnt(0)" ::: "memory");
    const int c = lane & 7;
#pragma unroll
    for (int j = 0; j < 4; ++j) { const int n = (lane >> 3) + 8 * j; const LAS float* s = scr + (8 * c) * 33 + n;
        u32x4 o; o.x = pk2(s[0 * 33], s[1 * 33]); o.y = pk2(s[2 * 33], s[3 * 33]); o.z = pk2(s[4 * 33], s[5 * 33]); o.w = pk2(s[6 * 33], s[7 * 33]);
        *(u32x4*)(d.dst + (size_t)(drow + n) * d.ldt + k0 + 8 * c) = o; }
    asm volatile("s_waitcnt lgkmcnt(0)" ::: "memory");
}
DI void transpose_mat(const TDesc& d, int& base, int gw, int NGW, LAS float* scr, int lane) {
    const int nblk = d.N / 32, nitems = (d.K / 64) * nblk;
    int first = (gw - base) % NGW; if (first < 0) first += NGW;
    for (int it = first; it < nitems; it += NGW) {
        const int kb = it / nblk, nb = it % nblk, k0 = 64 * kb, n0 = 32 * nb;
        int drow;
        if (d.map == 0) drow = d.rowadd + n0;
        else if (d.map == 1) drow = 256 * (n0 >> 7) + (n0 & 127) + d.rowadd;
        else drow = 256 * (n0 >> 8) + 128 * ((n0 >> 5) & 1) + 32 * ((n0 >> 6) & 3);
        transpose_item(d, k0, n0, drow, scr, lane);
    }
    base = (base + nitems) % NGW;
}

struct Params { const float* in[23]; float* out; unsigned char* ws; };

DI void p0_phase(const Params& P, unsigned char* lds, int G) {
    int tid_ = threadIdx.x; asm volatile("" : "+v"(tid_));
    const int tid = tid_, lane = tid & 63, wave = tid >> 6;
    unsigned char* ws = P.ws;
    LAS float* scr = (LAS float*)((LAS unsigned char*)lds + wave * 9216);
    const int gw = blockIdx.x * NWAVES + wave, NGW = G * NWAVES;
    int base = 0;
    for (int f = 0; f < 4; ++f) {
        bf16_t* wgu = (bf16_t*)(ws + WS_WGU) + (size_t)f * 5632 * 1024;
        { TDesc d{P.in[5] + (size_t)f * D * FF, FF, D, FF, wgu, D, 1, 0, nullptr}; transpose_mat(d, base, gw, NGW, scr, lane); }
        { TDesc d{P.in[6] + (size_t)f * D * FF, FF, D, FF, wgu, D, 1, 128, nullptr}; transpose_mat(d, base, gw, NGW, scr, lane); }
        { TDesc d{P.in[7] + (size_t)f * FF * D, D, FF, D, (bf16_t*)(ws + WS_WDN) + (size_t)f * D * FF, FF, 0, 0, nullptr}; transpose_mat(d, base, gw, NGW, scr, lane); }
    }
    { TDesc d{P.in[8], INW, D, PW, (bf16_t*)(ws + WS_WIN), D, 0, 0, nullptr}; transpose_mat(d, base, gw, NGW, scr, lane); }
    { TDesc d{P.in[9], D, D, D, (bf16_t*)(ws + WS_WOUT1), D, 0, 0, nullptr}; transpose_mat(d, base, gw, NGW, scr, lane); }
    { TDesc d{P.in[9] + (size_t)D * D, D, D, D, (bf16_t*)(ws + WS_WOUT2), D, 0, 0, P.in[18]}; transpose_mat(d, base, gw, NGW, scr, lane); }
    { TDesc d{P.in[19], 3 * D, D, 2 * D, (bf16_t*)(ws + WS_WQK), D, 2, 0, nullptr}; transpose_mat(d, base, gw, NGW, scr, lane); }
    { TDesc d{P.in[19] + 2 * D, 3 * D, D, D, (bf16_t*)(ws + WS_WV), D, 0, 0, nullptr}; transpose_mat(d, base, gw, NGW, scr, lane); }
    { TDesc d{P.in[22], D, D, D, (bf16_t*)(ws + WS_WO), D, 0, 0, nullptr}; transpose_mat(d, base, gw, NGW, scr, lane); }
    float* rowss = (float*)(ws + WS_ROWSS);
    for (int i = blockIdx.x * NTHREADS + tid; i < T; i += G * NTHREADS) rowss[i] = 0.f;
    __syncthreads();
    float* sc = (float*)(lds + 81920);
    float* part = (float*)(lds + 114688);
    for (int i = tid; i < NB * D; i += NTHREADS) sc[i] = silu_f(P.in[1][i]);
    __syncthreads();
    float* mod = (float*)(ws + WS_MOD);
    for (int item = blockIdx.x; item < 288; item += G) {
        const int l = item / 144, n0 = (item % 144) * 64;
        const float* W = P.in[2] + (size_t)l * D * MODW + n0 + lane;
        float acc[8];
#pragma unroll
        for (int b = 0; b < 8; ++b) acc[b] = 0.f;
#pragma unroll 8
        for (int kk = 0; kk < 128; ++kk) { const int k = wave * 128 + kk; const float wv = W[(size_t)k * MODW];
#pragma unroll
            for (int b = 0; b < 8; ++b) acc[b] += sc[b * D + k] * wv; }
#pragma unroll
        for (int b = 0; b < 8; ++b) part[(wave * 8 + b) * 64 + lane] = acc[b];
        __syncthreads();
        { const int b = tid >> 6, col = tid & 63; float s = 0.f;
#pragma unroll
            for (int w = 0; w < 8; ++w) s += part[(w * 8 + b) * 64 + col];
            mod[(size_t)(l * 8 + b) * MODW + n0 + col] = s + P.in[3][(size_t)l * MODW + n0 + col]; }
        __syncthreads();
    }
}

template <bool PRE, bool MAIN, bool DT>
DI void norm_phase(const float* src, float* hdst, const float* gpre, bf16_t* xn, const float* g, const float* modl, float* dtraw, const float* w_in, unsigned char* lds, int G) {
    int tid_ = threadIdx.x; asm volatile("" : "+v"(tid_));
    const int tid = tid_, lane = tid & 63, wave = tid >> 6;
    const int gw = blockIdx.x * NWAVES + wave, NGW = G * NWAVES;
    float* wl = (float*)lds;
    if (DT) { for (int idx = tid; idx < 16384; idx += NTHREADS) { const int k = idx >> 4, hh = idx & 15; wl[hh * 1024 + k] = w_in[(size_t)k * INW + PW + hh]; } __syncthreads(); }
    for (int m = gw; m < T; m += NGW) {
        const f32x4* xr = (const f32x4*)(src + (size_t)m * D) + lane;
        f32x4 v[4]; float ss = 0.f;
#pragma unroll
        for (int j = 0; j < 4; ++j) { v[j] = xr[64 * j]; ss += (v[j][0] * v[j][0] + v[j][1] * v[j][1]) + (v[j][2] * v[j][2] + v[j][3] * v[j][3]); }
        if (PRE) {
            const float rstd = rsqrtf(wave_sum(ss) * (1.f / D) + EPS); ss = 0.f;
            f32x4* ho = (f32x4*)(hdst + (size_t)m * D) + lane;
#pragma unroll
            for (int j = 0; j < 4; ++j) { const f32x4 gp = ((const f32x4*)gpre)[lane + 64 * j]; v[j] = v[j] * rstd * gp; ho[64 * j] = v[j];
                ss += (v[j][0] * v[j][0] + v[j][1] * v[j][1]) + (v[j][2] * v[j][2] + v[j][3] * v[j][3]); }
        }
        if (MAIN) {
            const float rstd = rsqrtf(wave_sum(ss) * (1.f / D) + EPS);
            const int b = m >> 12;
            const f32x4* sh = (const f32x4*)(modl + (size_t)b * MODW) + lane; const f32x4* scl = (const f32x4*)(modl + (size_t)b * MODW + D) + lane;
            u32x2* o8 = (u32x2*)(xn + (size_t)m * D) + lane;
#pragma unroll
            for (int j = 0; j < 4; ++j) { const f32x4 gg = ((const f32x4*)g)[lane + 64 * j]; const f32x4 y = v[j] * rstd * gg * (scl[64 * j] + 1.f) + sh[64 * j]; v[j] = y;
                u32x2 w; w.x = pk2(y[0], y[1]); w.y = pk2(y[2], y[3]); o8[64 * j] = w; }
            if (DT) {
                float d[16];
#pragma unroll
                for (int hh = 0; hh < 16; ++hh) { float a = 0.f;
#pragma unroll
                    for (int j = 0; j < 4; ++j) { const f32x4 w4 = *(const f32x4*)(wl + hh * 1024 + 4 * (lane + 64 * j)); a += (v[j][0] * w4[0] + v[j][1] * w4[1]) + (v[j][2] * w4[2] + v[j][3] * w4[3]); }
                    d[hh] = a; if ((hh & 3) == 3) asm volatile("" ::: "memory"); }
                { const bool hb = (lane & 32) != 0;
#pragma unroll
                    for (int i = 0; i < 8; ++i) { const float keep = hb ? d[i + 8] : d[i], send = hb ? d[i] : d[i + 8]; d[i] = keep + __shfl_xor(send, 32); } }
                { const bool hb = (lane & 16) != 0;
#pragma unroll
                    for (int i = 0; i < 4; ++i) { const float keep = hb ? d[i + 4] : d[i], send = hb ? d[i] : d[i + 4]; d[i] = keep + __shfl_xor(send, 16); } }
                { const bool hb = (lane & 8) != 0;
#pragma unroll
                    for (int i = 0; i < 2; ++i) { const float keep = hb ? d[i + 2] : d[i], send = hb ? d[i] : d[i + 2]; d[i] = keep + __shfl_xor(send, 8); } }
                { const bool hb = (lane & 4) != 0; const float keep = hb ? d[1] : d[0], send = hb ? d[0] : d[1]; d[0] = keep + __shfl_xor(send, 4); }
                d[0] += __shfl_xor(d[0], 1); d[0] += __shfl_xor(d[0], 2);
                const int hh = ((lane >> 5) & 1) * 8 + ((lane >> 4) & 1) * 4 + ((lane >> 3) & 1) * 2 + ((lane >> 2) & 1);
                if ((lane & 3) == 0) dtraw[(size_t)m * 16 + hh] = d[0];
            }
        }
    }
}

DI void gmlp_item(int item, bf16_t* PROJ, const float* vg, const float* wsp, const float* bsp, unsigned char* lds) {
    int tid_ = threadIdx.x; asm volatile("" : "+v"(tid_));
    const int tid = tid_, lane = tid & 63, wave = tid >> 6, fr = lane & 15, fq = lane >> 4;
    const int b = item >> 8, blk = (item >> 3) & 31, g = item & 7;
    const int r0 = b * SEQ + blk * 128;
    bf16_t* vnT = (bf16_t*)lds;
    bf16_t* Wm = vnT + 128 * 136;
    {
        const int row = tid >> 2, q4 = tid & 3;
        const bf16_t* vp = PROJ + (size_t)(r0 + row) * PW + 1024 + g * 128 + q4 * 32;
        u32x4 raw[4];
#pragma unroll
        for (int i = 0; i < 4; ++i) raw[i] = *(const u32x4*)(vp + 8 * i);
        float f[32]; float ss = 0.f;
#pragma unroll
        for (int i = 0; i < 4; ++i)
#pragma unroll
            for (int e = 0; e < 4; ++e) { const unsigned u = raw[i][e]; f[8 * i + 2 * e] = bflo(u); f[8 * i + 2 * e + 1] = bfhi(u); }
#pragma unroll
        for (int i = 0; i < 32; ++i) ss += f[i] * f[i];
        ss += __shfl_xor(ss, 1); ss += __shfl_xor(ss, 2);
        const float rstd = rsqrtf(ss * (1.f / 128.f) + EPS);
        const float* gp = vg + g * 128 + q4 * 32;
#pragma unroll
        for (int i = 0; i < 32; ++i) vnT[(q4 * 32 + i) * 136 + row] = (bf16_t)f2bf(f[i] * rstd * gp[i]);
        const float* wp = wsp + ((size_t)g * 128 + row) * 128 + q4 * 32;
#pragma unroll
        for (int i = 0; i < 8; ++i) { f32x4 w4 = *(const f32x4*)(wp + 4 * i);
            if (row < 64 && q4 >= 2) w4 = (f32x4){0.f, 0.f, 0.f, 0.f};
            u32x2 o; o.x = pk2(w4[0], w4[1]); o.y = pk2(w4[2], w4[3]); *(u32x2*)(Wm + row * 136 + q4 * 32 + 4 * i) = o; }
    }
    __syncthreads();
    f32x4 acc[8];
#pragma unroll
    for (int ct = 0; ct < 8; ++ct) acc[ct] = (f32x4){0.f, 0.f, 0.f, 0.f};
    const int nks = (wave < 4) ? 2 : 4;
    for (int ks = 0; ks < nks; ++ks) {
        const bf16x8 af = *(const bf16x8*)(Wm + (16 * wave + fr) * 136 + 32 * ks + 8 * fq);
#pragma unroll
        for (int ct = 0; ct < 8; ++ct) { const bf16x8 bfr = *(const bf16x8*)(vnT + (16 * ct + fr) * 136 + 32 * ks + 8 * fq);
            acc[ct] = __builtin_amdgcn_mfma_f32_16x16x32_bf16(bfr, af, acc[ct], 0, 0, 0); }
    }
    {
        const int t = 16 * wave + fr; const float bias = bsp[g * 128 + t];
        bf16_t* up = PROJ + (size_t)(r0 + t) * PW + g * 128 + 4 * fq;
#pragma unroll
        for (int ct = 0; ct < 8; ++ct) { const u32x2 u2 = *(const u32x2*)(up + 16 * ct);
            u32x2 o; o.x = pk2(bflo(u2.x) * (acc[ct][0] + bias), bfhi(u2.x) * (acc[ct][1] + bias)); o.y = pk2(bflo(u2.y) * (acc[ct][2] + bias), bfhi(u2.y) * (acc[ct][3] + bias));
            *(u32x2*)(up + 16 * ct) = o; }
    }
    __syncthreads();
}

DI void ssd_item(int item, bf16_t* PROJ, const float* dtraw, const float* conv_w, const float* conv_b, const float* dt_bias, const float* a_log, const float* dskip, float* rowss, unsigned char* lds) {
    int tid_ = threadIdx.x; asm volatile("" : "+v"(tid_));
    const int tid = tid_, lane = tid & 63, wave = tid >> 6, fr = lane & 15, fq = lane >> 4, r32 = lane & 31, hi = lane >> 5;
    const int b = item >> 4, hd = item & 15, g = hd >> 3;
    float* dtv = (float*)lds; float* csv = dtv + 4096;
    bf16_t* Cn = (bf16_t*)(lds + 32768);
    bf16_t* Bn = Cn + 64 * 136;
    bf16_t* BsT = Bn + 64 * 136;
    bf16_t* xsT = BsT + 128 * 72;
    bf16_t* Wl = xsT + 64 * 72;
    bf16_t* Hb = Wl + 64 * 72;
    const float Aneg = -__expf(a_log[hd]), dtb = dt_bias[hd], Dk = dskip[hd];
    for (int i = 0; i < 8; ++i) {
        const int t = (wave + 8 * i) * 64 + lane;
        const float raw = dtraw[(size_t)(b * SEQ + t) * 16 + hd] + dtb;
        const float dt = raw > 20.f ? raw : softplus_f(raw);
        float x = dt * Aneg;
#pragma unroll
        for (int o = 1; o < 64; o <<= 1) { const float y = __shfl_up(x, o); if (lane >= o) x += y; }
        dtv[t] = dt; csv[t] = x;
    }
    for (int idx = tid; idx < 64 * 136 / 2; idx += NTHREADS) ((unsigned*)Hb)[idx] = 0u;
    const bool active = tid < 320; const int cgp = tid % 40, rb = (tid / 40) & 7;
    const int col = cgp < 8 ? 3072 + hd * 64 + 8 * cgp : (cgp < 24 ? 4096 + g * 128 + 8 * (cgp - 8) : 4352 + g * 128 + 8 * (cgp - 24));
    const int ch0 = col - 3072;
    float* cwl = (float*)(lds + 121856);
    if (active) {
#pragma unroll
        for (int k = 0; k < 4; ++k)
#pragma unroll
            for (int i = 0; i < 8; ++i) cwl[k * 320 + cgp * 8 + i] = conv_w[k * 1536 + ch0 + i];
#pragma unroll
        for (int i = 0; i < 8; ++i) cwl[4 * 320 + cgp * 8 + i] = conv_b[ch0 + i];
    }
    f32x16 Hacc;
#pragma unroll
    for (int r = 0; r < 16; ++r) Hacc[r] = 0.f;
    u32x4 raw[11];
    const bf16_t* xcol = PROJ + (size_t)(b * SEQ) * PW + col;
#define SSD_LOAD_RAW(c) do { _Pragma("unroll") for (int i = 0; i < 11; ++i) { const int t = (c) * 64 + rb * 8 + i - 3; \
        raw[i] = (t >= 0) ? *(const u32x4*)(xcol + (size_t)t * PW) : (u32x4){0u, 0u, 0u, 0u}; } } while (0)
    if (active) SSD_LOAD_RAW(0);
    __syncthreads();
    const int tt = wave >> 1, half = wave & 1;
    for (int c = 0; c < 64; ++c) {
        const int tb = c * 64;
        if (active) {
            float o[8][8];
#pragma unroll
            for (int e = 0; e < 4; ++e) {
                const float* cwp = cwl + cgp * 8 + 2 * e;
                const float w00 = cwp[0], w01 = cwp[1], w10 = cwp[320], w11 = cwp[321], w20 = cwp[640], w21 = cwp[641], w30 = cwp[960], w31 = cwp[961], b0 = cwp[1280], b1 = cwp[1281];
#pragma unroll
                for (int i = 0; i < 8; ++i) {
                    const unsigned u0 = raw[i][e], u1 = raw[i + 1][e], u2 = raw[i + 2][e], u3 = raw[i + 3][e];
                    const float a0 = b0 + w00 * bflo(u0) + w10 * bflo(u1) + w20 * bflo(u2) + w30 * bflo(u3);
                    const float a1 = b1 + w01 * bfhi(u0) + w11 * bfhi(u1) + w21 * bfhi(u2) + w31 * bfhi(u3);
                    o[i][2 * e] = silu_f(a0); o[i][2 * e + 1] = silu_f(a1);
                }
            }
            if (cgp < 8) {
#pragma unroll
                for (int cc = 0; cc < 8; ++cc) { u32x4 w; w.x = pk2(o[0][cc], o[1][cc]); w.y = pk2(o[2][cc], o[3][cc]); w.z = pk2(o[4][cc], o[5][cc]); w.w = pk2(o[6][cc], o[7][cc]);
                    *(u32x4*)(xsT + (8 * cgp + cc) * 72 + rb * 8) = w; }
            } else if (cgp < 24) {
                const int n0 = 8 * (cgp - 8);
                const float cse = csv[tb + 63];
                float dte[8];
#pragma unroll
                for (int i = 0; i < 8; ++i) { const int t = tb + rb * 8 + i; dte[i] = __expf(cse - csv[t]) * dtv[t]; }
#pragma unroll
                for (int i = 0; i < 8; ++i) { u32x4 w; w.x = pk2(o[i][0], o[i][1]); w.y = pk2(o[i][2], o[i][3]); w.z = pk2(o[i][4], o[i][5]); w.w = pk2(o[i][6], o[i][7]);
                    *(u32x4*)(Bn + (rb * 8 + i) * 136 + n0) = w; }
#pragma unroll
                for (int cc = 0; cc < 8; ++cc) { u32x4 w; w.x = pk2(o[0][cc] * dte[0], o[1][cc] * dte[1]); w.y = pk2(o[2][cc] * dte[2], o[3][cc] * dte[3]);
                    w.z = pk2(o[4][cc] * dte[4], o[5][cc] * dte[5]); w.w = pk2(o[6][cc] * dte[6], o[7][cc] * dte[7]);
                    *(u32x4*)(BsT + (n0 + cc) * 72 + rb * 8) = w; }
            } else {
                const int n0 = 8 * (cgp - 24);
#pragma unroll
                for (int i = 0; i < 8; ++i) { u32x4 w; w.x = pk2(o[i][0], o[i][1]); w.y = pk2(o[i][2], o[i][3]); w.z = pk2(o[i][4], o[i][5]); w.w = pk2(o[i][6], o[i][7]);
                    *(u32x4*)(Cn + (rb * 8 + i) * 136 + n0) = w; }
            }
            if (c < 63) SSD_LOAD_RAW(c + 1);
        }
        __syncthreads();
        const int trow = 16 * tt + fr;
        bf16_t* zrow = PROJ + (size_t)(b * SEQ + tb + trow) * PW + 2048 + hd * 64 + 4 * fq;
        u32x2 zr[2];
#pragma unroll
        for (int p2 = 0; p2 < 2; ++p2) zr[p2] = *(const u32x2*)(zrow + 16 * (2 * half + p2));
        const float cs_t = csv[tb + trow];
        bf16x8 cf[4];
#pragma unroll
        for (int ks = 0; ks < 4; ++ks) cf[ks] = *(const bf16x8*)(Cn + trow * 136 + 32 * ks + 8 * fq);
#pragma unroll
        for (int s2 = 0; s2 < 2; ++s2) {
            const int st = 2 * half + s2;
            u32x2 w; w.x = 0u; w.y = 0u;
            if (st <= tt) {
                f32x4 ga = (f32x4){0.f, 0.f, 0.f, 0.f};
#pragma unroll
                for (int ks = 0; ks < 4; ++ks) { const bf16x8 bfr = *(const bf16x8*)(Bn + (16 * st + fr) * 136 + 32 * ks + 8 * fq);
                    ga = __builtin_amdgcn_mfma_f32_16x16x32_bf16(bfr, cf[ks], ga, 0, 0, 0); }
                float wv[4];
#pragma unroll
                for (int j = 0; j < 4; ++j) { const int s = 16 * st + 4 * fq + j;
                    float val = (s <= trow) ? ga[j] * __expf(cs_t - csv[tb + s]) * dtv[tb + s] : 0.f;
                    if (s == trow) val += Dk;
                    wv[j] = val; }
                w.x = pk2(wv[0], wv[1]); w.y = pk2(wv[2], wv[3]);
            }
            *(u32x2*)(Wl + trow * 72 + 16 * st + 4 * fq) = w;
        }
        f32x4 ya[2];
#pragma unroll
        for (int p2 = 0; p2 < 2; ++p2) { ya[p2] = (f32x4){0.f, 0.f, 0.f, 0.f}; const int pt = 2 * half + p2;
#pragma unroll
            for (int ks = 0; ks < 4; ++ks) { const bf16x8 hf = *(const bf16x8*)(Hb + (16 * pt + fr) * 136 + 32 * ks + 8 * fq);
                ya[p2] = __builtin_amdgcn_mfma_f32_16x16x32_bf16(hf, cf[ks], ya[p2], 0, 0, 0); }
            ya[p2] = ya[p2] * __expf(cs_t); }
        __syncthreads();
        {
            const int nks = (tt < 2) ? 1 : 2;
            for (int ks = 0; ks < nks; ++ks) { const bf16x8 wf = *(const bf16x8*)(Wl + trow * 72 + 32 * ks + 8 * fq);
#pragma unroll
                for (int p2 = 0; p2 < 2; ++p2) { const bf16x8 xf = *(const bf16x8*)(xsT + (16 * (2 * half + p2) + fr) * 72 + 32 * ks + 8 * fq);
                    ya[p2] = __builtin_amdgcn_mfma_f32_16x16x32_bf16(xf, wf, ya[p2], 0, 0, 0); } }
            float ss = 0.f;
#pragma unroll
            for (int p2 = 0; p2 < 2; ++p2) { const float z0 = bflo(zr[p2].x), z1 = bfhi(zr[p2].x), z2 = bflo(zr[p2].y), z3 = bfhi(zr[p2].y);
                const float y0 = ya[p2][0] * silu_f(z0), y1 = ya[p2][1] * silu_f(z1), y2 = ya[p2][2] * silu_f(z2), y3 = ya[p2][3] * silu_f(z3);
                ss += (y0 * y0 + y1 * y1) + (y2 * y2 + y3 * y3);
                u32x2 o; o.x = pk2(y0, y1); o.y = pk2(y2, y3); *(u32x2*)(zrow + 16 * (2 * half + p2)) = o; }
            ss += __shfl_xor(ss, 16); ss += __shfl_xor(ss, 32);
            if (fq == 0) atomicAdd(rowss + (size_t)(b * SEQ + tb + trow), ss);
            const int pp = wave >> 2, nn = wave & 3;
            const float cd = __expf(csv[tb + 63]);
#pragma unroll
            for (int r = 0; r < 16; ++r) Hacc[r] *= cd;
#pragma unroll
            for (int ks = 0; ks < 4; ++ks) { const bf16x8 bf = *(const bf16x8*)(BsT + (32 * nn + r32) * 72 + 16 * ks + 8 * hi);
                const bf16x8 xf = *(const bf16x8*)(xsT + (32 * pp + r32) * 72 + 16 * ks + 8 * hi);
                Hacc = __builtin_amdgcn_mfma_f32_32x32x16_bf16(bf, xf, Hacc, 0, 0, 0); }
#pragma unroll
            for (int r4 = 0; r4 < 4; ++r4) { u32x2 o; o.x = pk2(Hacc[4 * r4], Hacc[4 * r4 + 1]); o.y = pk2(Hacc[4 * r4 + 2], Hacc[4 * r4 + 3]);
                *(u32x2*)(Hb + (32 * pp + r32) * 136 + 32 * nn + 8 * r4 + 4 * hi) = o; }
        }
        __syncthreads();
    }
#undef SSD_LOAD_RAW
}

DI int pi32(int m) { return (m & ~12) | ((m & 4) << 1) | ((m & 8) >> 1); }
DI void attn_phase(const bf16_t* Q, const bf16_t* Kg, const bf16_t* Vt, bf16_t* O, unsigned char* lds, int G) {
    int tid_ = threadIdx.x; asm volatile("" : "+v"(tid_));
    const int tid = tid_, lane = tid & 63, wave = tid >> 6, r32 = lane & 31, hi = lane >> 5;
    const int key = tid >> 3, ch = tid & 7, stoff = key * 144 + ch * 16;
    const int krow = pi32(r32);
    for (int v = blockIdx.x; v < 256; v += G) {
        const int bh = v >> 1, par = v & 1, b = bh >> 4, hd = bh & 15;
        const bf16_t* kgp = Kg + (size_t)(b * SEQ + key) * D + hd * 64 + 8 * ch;
        const bf16_t* vgp = Vt + (size_t)(hd * 64 + key) * T + b * SEQ + 8 * ch;
        for (int ui = 0; ui < 8; ++ui) {
            const int s_ = par * 4 + (ui >> 1), qb = (ui & 1) ? 15 - s_ : s_;
            const int q0 = qb * 256, qw = q0 + 32 * wave, NT = 4 * qb + 4, tq = qw >> 6;
            const bf16_t* qp = Q + (size_t)(b * SEQ + qw + r32) * D + hd * 64 + 8 * hi;
            bf16x8 qf[4];
#pragma unroll
            for (int d0 = 0; d0 < 4; ++d0) qf[d0] = *(const bf16x8*)(qp + 16 * d0);
            f32x16 o0, o1;
#pragma unroll
            for (int r = 0; r < 16; ++r) { o0[r] = 0.f; o1[r] = 0.f; }
            float run = 0.f;
            u32x4 kr = *(const u32x4*)(kgp + (size_t)(NT - 1) * 64 * D), vr = *(const u32x4*)(vgp + (NT - 1) * 64);
            *(u32x4*)(lds + stoff) = kr; *(u32x4*)(lds + 9216 + stoff) = vr;
            __syncthreads();
            int buf = 0;
            for (int i = NT - 1; i >= 0; --i, buf ^= 1) {
                if (i > 0) { kr = *(const u32x4*)(kgp + (size_t)(i - 1) * 64 * D); vr = *(const u32x4*)(vgp + (i - 1) * 64); }
                if (i <= tq) {
                    const unsigned char* Kl = lds + buf * 18432; const unsigned char* Vl = Kl + 9216;
                    f32x16 p[2];
#pragma unroll
                    for (int kb = 0; kb < 2; ++kb) {
#pragma unroll
                        for (int r = 0; r < 16; ++r) p[kb][r] = 0.f;
#pragma unroll
                        for (int d0 = 0; d0 < 4; ++d0) { const bf16x8 kf = *(const bf16x8*)(Kl + (32 * kb + krow) * 144 + (16 * d0 + 8 * hi) * 2);
                            p[kb] = __builtin_amdgcn_mfma_f32_32x32x16_bf16(kf, qf[d0], p[kb], 0, 0, 0); }
                    }
                    const bool masked = (i == tq);
                    float lk[2][16];
#pragma unroll
                    for (int kb = 0; kb < 2; ++kb)
#pragma unroll
                        for (int r = 0; r < 16; ++r) {
                            const float z = p[kb][r];
                            const float sp = fmaxf(z, 0.f) + lg2(1.f + ex2(-fabsf(z)));
                            float lkv = -sp, lb = z - sp;
                            if (masked) { const int ka = 64 * i + 32 * kb + 16 * (r >> 3) + 8 * hi + (r & 7); const bool valid = ka < qw + r32; lkv = valid ? lkv : 0.f; lb = valid ? lb : -INFINITY; }
                            lk[kb][r] = lkv; p[kb][r] = lb;
                        }
                    float glo[2][2], ghi[2][2];
#pragma unroll
                    for (int kb = 0; kb < 2; ++kb)
#pragma unroll
                        for (int s = 0; s < 2; ++s) { float gs = 0.f;
#pragma unroll
                            for (int j = 0; j < 8; ++j) gs += lk[kb][8 * s + j];
                            auto rr = __builtin_amdgcn_permlane32_swap(__float_as_uint(gs), __float_as_uint(gs), false, false);
                            glo[kb][s] = __uint_as_float(rr[0]); ghi[kb][s] = __uint_as_float(rr[1]); }
                    float basev = run;
#pragma unroll
                    for (int kb = 1; kb >= 0; --kb)
#pragma unroll
                        for (int s = 1; s >= 0; --s) {
                            float a = basev + (hi == 0 ? ghi[kb][s] : 0.f);
#pragma unroll
                            for (int j = 7; j >= 0; --j) { const float w = ex2(p[kb][8 * s + j] + a); a += lk[kb][8 * s + j]; p[kb][8 * s + j] = w; }
                            basev += glo[kb][s] + ghi[kb][s];
                        }
                    run = basev;
#pragma unroll
                    for (int kb = 0; kb < 2; ++kb)
#pragma unroll
                        for (int s = 0; s < 2; ++s) {
                            u32x4 pw; pw.x = cvt_pk_bf16(p[kb][8 * s + 0], p[kb][8 * s + 1]); pw.y = cvt_pk_bf16(p[kb][8 * s + 2], p[kb][8 * s + 3]);
                            pw.z = cvt_pk_bf16(p[kb][8 * s + 4], p[kb][8 * s + 5]); pw.w = cvt_pk_bf16(p[kb][8 * s + 6], p[kb][8 * s + 7]);
                            const bf16x8 pa = __builtin_bit_cast(bf16x8, pw);
                            const bf16x8 v0 = *(const bf16x8*)(Vl + (r32) * 144 + (32 * kb + 16 * s + 8 * hi) * 2);
                            const bf16x8 v1 = *(const bf16x8*)(Vl + (32 + r32) * 144 + (32 * kb + 16 * s + 8 * hi) * 2);
                            o0 = __builtin_amdgcn_mfma_f32_32x32x16_bf16(pa, v0, o0, 0, 0, 0);
                            o1 = __builtin_amdgcn_mfma_f32_32x32x16_bf16(pa, v1, o1, 0, 0, 0);
                        }
                }
                if (i > 0) { *(u32x4*)(lds + (buf ^ 1) * 18432 + stoff) = kr; *(u32x4*)(lds + (buf ^ 1) * 18432 + 9216 + stoff) = vr; }
                __syncthreads();
            }
            bf16_t* op = O + (size_t)(b * SEQ + qw) * D + hd * 64 + r32;
#pragma unroll
            for (int r = 0; r < 16; ++r) { const int qrow = (r & 3) + 8 * (r >> 2) + 4 * hi;
                op[(size_t)qrow * D] = (bf16_t)f2bf(o0[r]); op[(size_t)qrow * D + 32] = (bf16_t)f2bf(o1[r]); }
        }
    }
}

#ifndef PM
#define PM 0xFFFF
#endif
#define PH(bit) if constexpr ((PM >> (bit)) & 1)
__global__ void __launch_bounds__(NTHREADS, 2) fwd_megakernel(Params P) {
    extern __shared__ __attribute__((aligned(16))) unsigned char lds[];
    cg::grid_group grid = cg::this_grid();
    const int G = gridDim.x, bid = blockIdx.x;
    unsigned char* ws = P.ws;
    LAS unsigned char* ldsl = (LAS unsigned char*)lds;
    float* mod = (float*)(ws + WS_MOD);
    float* rowss = (float*)(ws + WS_ROWSS);
    float* dtraw = (float*)(ws + WS_DT);
    bf16_t* XN = (bf16_t*)(ws + WS_XN);
    bf16_t* BIG = (bf16_t*)(ws + WS_BIG);
    float* H = P.out;
    const float* normg = P.in[4];

    PH(0) p0_phase(P, lds, G);
    grid.sync();

    for (int l = 0; l < 2; ++l) {
        const float* modl = mod + (size_t)l * 8 * MODW;
        PH(1) { if (l == 0) norm_phase<false, true, false>(P.in[0], nullptr, nullptr, XN, normg + (l * 4 + 0) * D, modl + 0 * 3072, nullptr, nullptr, lds, G);
        else        norm_phase<true, true, false>(H, H, normg + (0 * 4 + 3) * D, XN, normg + (l * 4 + 0) * D, modl + 0 * 3072, nullptr, nullptr, lds, G); }
        grid.sync();
        for (int i = 0; i < 2; ++i) {
            const int f = l * 2 + i;
            if (i == 1) { PH(1) norm_phase<false, true, false>(H, nullptr, nullptr, XN, normg + (l * 4 + 2) * D, modl + 2 * 3072, nullptr, nullptr, lds, G); grid.sync(); }
            PH(2) { pg8::Gemm g{XN, (const bf16_t*)(ws + WS_WGU) + (size_t)f * 5632 * 1024, T, 5632, D, D}; pg8::StaticOrder S; S.init(T, 5632, G, bid);
              pg8::EpiSwiGLU E{BIG}; pg8::gemm_phase(ldsl, g, S, E); }
            grid.sync();
            PH(3) { pg8::Gemm g{BIG, (const bf16_t*)(ws + WS_WDN) + (size_t)f * D * FF, T, D, FF, FF}; pg8::StaticOrder S; S.init(T, D, G, bid);
              pg8::EpiResid<1, false> E{(l == 0 && i == 0) ? P.in[0] : H, H, modl + (i == 0 ? 0 : 2) * 3072 + 2048, rowss}; pg8::gemm_phase(ldsl, g, S, E); }
            grid.sync();
            if (i == 0) {
                if (l == 0) {
                    PH(1) norm_phase<false, true, true>(H, nullptr, nullptr, XN, normg + (l * 4 + 1) * D, modl + 1 * 3072, dtraw, P.in[8], lds, G);
                    grid.sync();
                    PH(4) { pg8::Gemm g{XN, (const bf16_t*)(ws + WS_WIN), T, PW, D, D}; pg8::StaticOrder S; S.init(T, PW, G, bid);
                      pg8::EpiProj E{BIG}; pg8::gemm_phase(ldsl, g, S, E); }
                    grid.sync();
                    if (G >= 256) {
                        if (bid < 128) { PH(5) ssd_item(bid, BIG, dtraw, P.in[13], P.in[14], P.in[15], P.in[16], P.in[17], rowss, lds); }
                        else { PH(6) for (int it = bid - 128; it < 2048; it += G - 128) gmlp_item(it, BIG, P.in[10], P.in[11], P.in[12], lds); }
                    } else {
                        PH(5) for (int it = bid; it < 128; it += G) { ssd_item(it, BIG, dtraw, P.in[13], P.in[14], P.in[15], P.in[16], P.in[17], rowss, lds); __syncthreads(); }
                        PH(6) for (int it = bid; it < 2048; it += G) gmlp_item(it, BIG, P.in[10], P.in[11], P.in[12], lds);
                    }
                    grid.sync();
                    PH(7) { pg8::Gemm g{BIG, (const bf16_t*)(ws + WS_WOUT1), T, D, D, PW}; pg8::StaticOrder S; S.init(T, D, G, bid);
                      pg8::EpiResid<2, false> E{H, H, modl + 1 * 3072 + 2048, rowss}; pg8::gemm_phase(ldsl, g, S, E); }
                    PH(7) { pg8::Gemm g{BIG + 2048, (const bf16_t*)(ws + WS_WOUT2), T, D, D, PW}; pg8::StaticOrder S; S.init(T, D, G, bid);
                      pg8::EpiResid<2, true> E{H, H, modl + 1 * 3072 + 2048, rowss}; pg8::gemm_phase(ldsl, g, S, E); }
                    grid.sync();
                } else {
                    PH(1) norm_phase<false, true, false>(H, nullptr, nullptr, XN, normg + (l * 4 + 1) * D, modl + 1 * 3072, nullptr, nullptr, lds, G);
                    grid.sync();
                    PH(8) { pg8::Gemm g{XN, (const bf16_t*)(ws + WS_WQK), T, 2 * D, D, D}; pg8::StaticOrder S; S.init(T, 2 * D, G, bid);
                      pg8::EpiQK E{(bf16_t*)(ws + WS_Q), (bf16_t*)(ws + WS_K), P.in[20], P.in[21], 0.125f * LOG2E}; pg8::gemm_phase(ldsl, g, S, E); }
                    PH(8) { pg8::Gemm g{(const bf16_t*)(ws + WS_WV), XN, D, T, D, D}; pg8::StaticOrder S; S.init(D, T, G, bid);
                      pg8::EpiPlain E{(bf16_t*)(ws + WS_VT), T}; pg8::gemm_phase(ldsl, g, S, E); }
                    grid.sync();
                    PH(9) attn_phase((const bf16_t*)(ws + WS_Q), (const bf16_t*)(ws + WS_K), (const bf16_t*)(ws + WS_VT), XN, lds, G);
                    grid.sync();
                    PH(10) { pg8::Gemm g{XN, (const bf16_t*)(ws + WS_WO), T, D, D, D}; pg8::StaticOrder S; S.init(T, D, G, bid);
                      pg8::EpiResid<2, false> E{H, H, modl + 1 * 3072 + 2048, rowss}; pg8::gemm_phase(ldsl, g, S, E); }
                    grid.sync();
                }
            }
        }
    }
    PH(1) norm_phase<true, false, false>(H, H, normg + (1 * 4 + 3) * D, nullptr, nullptr, nullptr, nullptr, nullptr, lds, G);
}

extern "C" void kernel_launch(void* const* d_in, const int* in_sizes, int n_in, void* d_out, int out_size, void* d_ws, size_t ws_size, hipStream_t stream) {
    static int grid = 0;
    if (grid == 0) {
        if (n_in != 23 || out_size != T * D || ws_size < WS_END) { fprintf(stderr, "kernel_launch: unexpected shapes (n_in %d out %d ws %zu)\n", n_in, out_size, ws_size); grid = -1; return; }
        int dev = 0, cus = 0, per_cu = 0;
        hipGetDevice(&dev);
        hipDeviceGetAttribute(&cus, hipDeviceAttributeMultiprocessorCount, dev);
        hipFuncSetAttribute((const void*)fwd_megakernel, hipFuncAttributeMaxDynamicSharedMemorySize, LDS_BYTES);
        hipOccupancyMaxActiveBlocksPerMultiprocessor(&per_cu, (const void*)fwd_megakernel, NTHREADS, LDS_BYTES);
        if (per_cu < 1) per_cu = 1;
        grid = cus * per_cu;
        (void)hipGetLastError();
    }
    if (grid < 0) return;
    Params p{};
    for (int i = 0; i < 23; ++i) p.in[i] = (const float*)d_in[i];
    p.out = (float*)d_out; p.ws = (unsigned char*)d_ws;
    void* args[] = {&p};
    hipError_t e = hipLaunchCooperativeKernel((const void*)fwd_megakernel, dim3(grid), dim3(NTHREADS), args, LDS_BYTES, stream);
    if (e != hipSuccess) fprintf(stderr, "cooperative launch failed: %s (grid %d)\n", hipGetErrorString(e), grid);
}
```

```cpp
#include <hip/hip_runtime.h>
#include <hip/hip_cooperative_groups.h>
#include <cstdio>
#include <cstdint>
namespace cg = cooperative_groups;

#define DI __device__ __forceinline__
#define LAS __attribute__((address_space(3)))
typedef unsigned short bf16_t;
typedef short bf16x8 __attribute__((ext_vector_type(8)));
typedef float f32x4 __attribute__((ext_vector_type(4)));
typedef float f32x16 __attribute__((ext_vector_type(16)));
typedef unsigned u32x4 __attribute__((ext_vector_type(4)));
typedef unsigned u32x2 __attribute__((ext_vector_type(2)));

constexpr int T = 32768, D = 1024, FF = 2816, SEQ = 4096, NB = 8;
constexpr int INW = 4624, PW = 4608;
constexpr int MODW = 9216;
constexpr float EPS = 1e-6f;
constexpr float LOG2E = 1.4426950408889634f, LN2 = 0.6931471805599453f;
constexpr int NTHREADS = 512, NWAVES = 8;
constexpr int LDS_BYTES = 147456;

constexpr size_t MiB = 1u << 20;
constexpr size_t WS_MOD = 0;
constexpr size_t WS_ROWSS = 1 * MiB;
constexpr size_t WS_DT = 2 * MiB;
constexpr size_t WS_WGU = 4 * MiB;
constexpr size_t WS_WDN = 48 * MiB;
constexpr size_t WS_WIN = 70 * MiB;
constexpr size_t WS_WOUT1 = 79 * MiB, WS_WOUT2 = 81 * MiB;
constexpr size_t WS_WQK = 83 * MiB;
constexpr size_t WS_WV = 87 * MiB, WS_WO = 89 * MiB;
constexpr size_t WS_XN = 92 * MiB;
constexpr size_t WS_BIG = 156 * MiB;
constexpr size_t WS_Q = WS_BIG, WS_K = WS_BIG + 64 * MiB, WS_VT = WS_BIG + 128 * MiB;
constexpr size_t WS_END = 444 * MiB;

DI unsigned f2bf(float f) { unsigned u = __builtin_bit_cast(unsigned, f); return (u + 0x7fffu + ((u >> 16) & 1u)) >> 16; }
typedef float f32x2_t __attribute__((ext_vector_type(2))); typedef __bf16 bf16x2_t __attribute__((ext_vector_type(2)));
DI unsigned cvt_pk_bf16(float lo, float hi) { f32x2_t v = {lo, hi}; bf16x2_t b = __builtin_convertvector(v, bf16x2_t); return __builtin_bit_cast(unsigned, b); }
DI unsigned pk2(float lo, float hi) { return cvt_pk_bf16(lo, hi); }
DI float bflo(unsigned u) { return __uint_as_float(u << 16); }
DI float bfhi(unsigned u) { return __uint_as_float(u & 0xffff0000u); }
DI float ex2(float x) { return __builtin_amdgcn_exp2f(x); }
DI float lg2(float x) { return __builtin_amdgcn_logf(x); }
DI float rcpf_(float x) { return __builtin_amdgcn_rcpf(x); }
DI float silu_f(float x) { return x * rcpf_(1.f + ex2(-x * LOG2E)); }
DI float gelu_tanh_f(float x) { const float u = 0.7978845608028654f * (x + 0.044715f * x * x * x); return x * rcpf_(1.f + ex2(-2.f * LOG2E * u)); }
DI float softplus_f(float x) { return fmaxf(x, 0.f) + LN2 * lg2(1.f + ex2(-fabsf(x) * LOG2E)); }
DI float wave_sum(float v) {
#pragma unroll
    for (int o = 1; o < 64; o <<= 1) v += __shfl_xor(v, o);
    return v;
}

namespace pg8 {
constexpr int BM = 256, BK = 64, HALF = 128, HTB = HALF * BK * 2, STAGE_BYTES = 8 * HTB, NXCD = 8, WGM = 8;
DI int lds_byte(int r, int c) { const int st = (r >> 4) * 2 + (c >> 5), rr = r & 15, cc = c & 31, ob = rr * 64 + cc * 2; return st * 1024 + (ob ^ (((ob >> 9) & 1) << 5)); }
DI void stage_rc(int b, int& R, int& C) { const int st = b / 1024, sb = b % 1024, swz = sb ^ (((sb >> 9) & 1) << 5); R = (st >> 1) * 16 + swz / 64; C = (st & 1) * 32 + (swz % 64) / 2; }
DI int perm32(int rho) { const int n = rho >> 4, i = rho & 15; return 8 * (i >> 2) + 4 * n + (i & 3); }

struct Unit { int pm, pn; };
struct Gemm { const bf16_t* A; const bf16_t* Bt; int M, N, K, lda; };

struct StaticOrder {
    int nM, nN, nwg, G, c;
    DI void init(int M, int N, int G_, int c_) { nM = M / BM; nN = N / BM; nwg = nM * nN; G = G_; c = c_; }
    DI bool next(int i, Unit& u) const {
        const long L = (long)i * G + c; if (L >= nwg) return false;
        int wgid = (int)L; { const int q = nwg / NXCD, r = nwg % NXCD, xcd = wgid % NXCD, off = wgid / NXCD; wgid = (xcd < r ? xcd * (q + 1) : r * (q + 1) + (xcd - r) * q) + off; }
        const int nig = WGM * nN, gid = wgid / nig, fm = gid * WGM, gsz = (nM - fm) < WGM ? (nM - fm) : WGM;
        u.pm = fm + ((wgid % nig) % gsz); u.pn = (wgid % nig) / gsz; return true;
    }
};

template <class Epi>
DI void gemm_phase(LAS unsigned char* lds, const Gemm g, const StaticOrder& S, const Epi& E) {
    int tid_ = threadIdx.x; asm volatile("" : "+v"(tid_));
    const int tid = tid_, wid = __builtin_amdgcn_readfirstlane(tid >> 6), lane = tid & 63, wr = wid >> 2, wc = wid & 3, fr = lane & 15, fq = lane >> 4;
    const int K = g.K, nt = K / BK, lda = g.lda;
    unsigned voffA[2], voffB[2];
#pragma unroll
    for (int i = 0; i < 2; ++i) { int R, C; stage_rc(tid * 16 + i * 8192, R, C); const int Rb = (R & ~31) + perm32(R & 31);
        voffA[i] = (unsigned)(R * lda + C) * 2u; voffB[i] = (unsigned)(Rb * K + C) * 2u; }
    const size_t kstep = (size_t)(BK * 2);
    const size_t hstepA = (size_t)HALF * lda * 2, hstepB = (size_t)HALF * K * 2;
    const size_t tstepA = 2 * hstepA, tstepB = 2 * hstepB;
    const unsigned ldsw = (unsigned)wid * 1024u;
    const int aoff = lds_byte(wr * 64 + fr, fq * 8), boff = lds_byte(wc * 32 + fr, fq * 8);
#define PG8_SA(b, h) (((b) * 2 + (h)) * HTB)
#define PG8_SB(b, h) ((4 + (b) * 2 + (h)) * HTB)
#define PG8_STAGE(bufoff, gbase, voff) do { _Pragma("unroll") for (int _i = 0; _i < 2; ++_i) \
        __builtin_amdgcn_global_load_lds((const unsigned*)((const char*)(gbase) + (voff)[_i]), (LAS unsigned*)(lds + (bufoff) + ldsw + _i * 8192), 16, 0, 0); } while (0)
#define PG8_LDA(dst, b, h) do { _Pragma("unroll") for (int m = 0; m < 4; ++m) _Pragma("unroll") for (int k = 0; k < 2; ++k) dst[m][k] = *(const LAS bf16x8*)(lds + PG8_SA(b, h) + aoff + m * 2048 + k * 1024); } while (0)
#define PG8_LDB(dst, b, h) do { _Pragma("unroll") for (int n = 0; n < 2; ++n) _Pragma("unroll") for (int k = 0; k < 2; ++k) dst[n][k] = *(const LAS bf16x8*)(lds + PG8_SB(b, h) + boff + n * 2048 + k * 1024); } while (0)
#define PG8_MMA(ai, bj, At, Bt) do { __builtin_amdgcn_s_setprio(1); _Pragma("unroll") for (int m = 0; m < 4; ++m) _Pragma("unroll") for (int n = 0; n < 2; ++n) _Pragma("unroll") for (int k = 0; k < 2; ++k) \
        acc[ai][bj][m][n] = __builtin_amdgcn_mfma_f32_16x16x32_bf16(Bt[n][k], At[m][k], acc[ai][bj][m][n], 0, 0, 0); __builtin_amdgcn_s_setprio(0); } while (0)
#define PG8_WAIT_V(n) asm volatile("s_waitcnt vmcnt(" #n ")" ::: "memory")
#define PG8_WAIT_L(n) asm volatile("s_waitcnt lgkmcnt(" #n ")" ::: "memory")
#define PG8_BAR __builtin_amdgcn_s_barrier()
#define PG8_SCHED __builtin_amdgcn_sched_barrier(0)
    Unit cur, nxt; int ui = 0;
    if (!S.next(0, cur)) return;
    f32x4 acc[2][2][4][2];
#pragma unroll
    for (int a = 0; a < 2; ++a)
#pragma unroll
        for (int b = 0; b < 2; ++b)
#pragma unroll
            for (int m = 0; m < 4; ++m)
#pragma unroll
                for (int n = 0; n < 2; ++n) acc[a][b][m][n] = (f32x4){0.f, 0.f, 0.f, 0.f};
    bf16x8 At[4][2], B0[2][2], B1[2][2];
    const char* cA = (const char*)g.A + (size_t)cur.pm * tstepA; const char* cB = (const char*)g.Bt + (size_t)cur.pn * tstepB;
    PG8_STAGE(PG8_SB(0, 0), cB, voffB); PG8_STAGE(PG8_SB(0, 1), cB + hstepB, voffB); PG8_STAGE(PG8_SA(0, 0), cA, voffA); PG8_STAGE(PG8_SA(0, 1), cA + hstepA, voffA);
    if (wr == 1) PG8_BAR;
    PG8_WAIT_V(2); PG8_BAR;
    PG8_STAGE(PG8_SB(1, 0), cB + kstep, voffB); PG8_STAGE(PG8_SA(1, 0), cA + kstep, voffA); PG8_STAGE(PG8_SB(1, 1), cB + hstepB + kstep, voffB);
    PG8_WAIT_V(6); PG8_BAR;
    for (;;) {
        const bool has_next = S.next(ui + 1, nxt);
        const char* nA = has_next ? (const char*)g.A + (size_t)nxt.pm * tstepA : cA; const char* nB = has_next ? (const char*)g.Bt + (size_t)nxt.pn * tstepB : cB;
        for (int t = 0; t < nt; t += 2) {
            const bool last = (t == nt - 2);
            const char* a1 = cA + (size_t)(t + 1) * kstep;
            const char* a2 = last ? nA : cA + (size_t)(t + 2) * kstep; const char* b2 = last ? nB : cB + (size_t)(t + 2) * kstep;
            const char* a3 = a2 + kstep; const char* b3 = b2 + kstep;
            PG8_LDB(B0, 0, 0); PG8_LDB(B1, 0, 1); PG8_SCHED; PG8_LDA(At, 0, 0); PG8_STAGE(PG8_SA(1, 1), a1 + hstepA, voffA);
            PG8_WAIT_V(8); PG8_WAIT_L(0); PG8_BAR; PG8_MMA(0, 0, At, B0); PG8_MMA(0, 1, At, B1); PG8_BAR; PG8_SCHED;
            PG8_LDA(At, 0, 1); PG8_STAGE(PG8_SB(0, 0), b2, voffB); PG8_STAGE(PG8_SB(0, 1), b2 + hstepB, voffB); PG8_STAGE(PG8_SA(0, 0), a2, voffA);
            PG8_WAIT_V(8); PG8_WAIT_L(0); PG8_BAR; PG8_MMA(1, 0, At, B0); PG8_MMA(1, 1, At, B1); PG8_BAR; PG8_SCHED;
            PG8_LDB(B0, 1, 0); PG8_LDB(B1, 1, 1); PG8_SCHED; PG8_LDA(At, 1, 0); PG8_STAGE(PG8_SA(0, 1), a2 + hstepA, voffA);
            PG8_WAIT_V(8); PG8_WAIT_L(0); PG8_BAR; PG8_MMA(0, 0, At, B0); PG8_MMA(0, 1, At, B1); PG8_BAR; PG8_SCHED;
            PG8_LDA(At, 1, 1); PG8_STAGE(PG8_SB(1, 0), b3, voffB); PG8_STAGE(PG8_SB(1, 1), b3 + hstepB, voffB); PG8_STAGE(PG8_SA(1, 0), a3, voffA);
            PG8_WAIT_V(8); PG8_WAIT_L(0); PG8_BAR; PG8_MMA(1, 0, At, B0); PG8_MMA(1, 1, At, B1); PG8_BAR; PG8_SCHED;
        }
        if (wr == 0) PG8_BAR;
        E(acc, cur, wr, wc, fr, fq);
        if (!has_next) break;
#pragma unroll
        for (int a = 0; a < 2; ++a)
#pragma unroll
            for (int b = 0; b < 2; ++b)
#pragma unroll
                for (int m = 0; m < 4; ++m)
#pragma unroll
                    for (int n = 0; n < 2; ++n) acc[a][b][m][n] = (f32x4){0.f, 0.f, 0.f, 0.f};
        cur = nxt; cA = nA; cB = nB; ++ui;
        if (wr == 1) PG8_BAR;
    }
    PG8_WAIT_V(0);
    PG8_BAR;
#undef PG8_SA
#undef PG8_SB
#undef PG8_STAGE
#undef PG8_LDA
#undef PG8_LDB
#undef PG8_MMA
#undef PG8_WAIT_V
#undef PG8_WAIT_L
#undef PG8_BAR
#undef PG8_SCHED
}

typedef f32x4 Acc[2][2][4][2];

struct EpiSwiGLU {
    bf16_t* O;
    DI void operator()(const Acc& acc, const Unit& u, int wr, int wc, int fr, int fq) const {
        const int row0 = u.pm * BM + wr * 64 + fr, col0 = u.pn * 128 + wc * 32 + 8 * fq;
#pragma unroll
        for (int ai = 0; ai < 2; ++ai)
#pragma unroll
            for (int m = 0; m < 4; ++m) {
                bf16_t* rowp = O + (size_t)(row0 + ai * HALF + m * 16) * FF + col0;
                const f32x4 g0 = acc[ai][0][m][0], g1 = acc[ai][0][m][1], u0 = acc[ai][1][m][0], u1 = acc[ai][1][m][1];
                u32x4 w;
                w.x = cvt_pk_bf16(silu_f(g0[0]) * u0[0], silu_f(g0[1]) * u0[1]); w.y = cvt_pk_bf16(silu_f(g0[2]) * u0[2], silu_f(g0[3]) * u0[3]);
                w.z = cvt_pk_bf16(silu_f(g1[0]) * u1[0], silu_f(g1[1]) * u1[1]); w.w = cvt_pk_bf16(silu_f(g1[2]) * u1[2], silu_f(g1[3]) * u1[3]);
                *(u32x4*)rowp = w;
            }
    }
};
template <int CS2, bool RS> struct EpiResid {
    const float* base; float* out; const float* gate; const float* rowss;
    DI void operator()(const Acc& acc, const Unit& u, int wr, int wc, int fr, int fq) const {
        const float* const base = this->base; float* const out = this->out; const float* const gate = this->gate; const float cscale = 0.5f * CS2; const float* const rowss = this->rowss;
        const int b = (u.pm * BM) >> 12;
        const int row0 = u.pm * BM + wr * 64 + fr, col0 = u.pn * BM + wc * 32 + 8 * fq;
        f32x4 gv[2][2];
#pragma unroll
        for (int bj = 0; bj < 2; ++bj)
#pragma unroll
            for (int n = 0; n < 2; ++n) gv[bj][n] = *(const f32x4*)(gate + (size_t)b * MODW + col0 + bj * HALF + 4 * n) * cscale;
#pragma unroll
        for (int ai = 0; ai < 2; ++ai)
#pragma unroll
            for (int m = 0; m < 4; ++m) {
                const int row = row0 + ai * HALF + m * 16;
                float rs = 1.f; if (RS) rs = rsqrtf(rowss[row] * (1.f / 1024.f) + EPS);
                const size_t off = (size_t)row * D + col0;
#pragma unroll
                for (int bj = 0; bj < 2; ++bj)
#pragma unroll
                    for (int n = 0; n < 2; ++n) { const f32x4 bs = *(const f32x4*)(base + off + bj * HALF + 4 * n);
                        *(f32x4*)(out + off + bj * HALF + 4 * n) = bs + gv[bj][n] * rs * acc[ai][bj][m][n]; }
                if (m & 1) asm volatile("" ::: "memory");
            }
    }
};
struct EpiProj {
    bf16_t* O;
    DI void operator()(const Acc& acc, const Unit& u, int wr, int wc, int fr, int fq) const {
        const int row0 = u.pm * BM + wr * 64 + fr, col0 = u.pn * BM + wc * 32 + 8 * fq;
        const bool act = u.pn < 8;
#pragma unroll
        for (int ai = 0; ai < 2; ++ai)
#pragma unroll
            for (int m = 0; m < 4; ++m) {
                bf16_t* rowp = O + (size_t)(row0 + ai * HALF + m * 16) * PW + col0;
#pragma unroll
                for (int bj = 0; bj < 2; ++bj) { f32x4 v0 = acc[ai][bj][m][0], v1 = acc[ai][bj][m][1];
                    if (act) {
#pragma unroll
                        for (int i = 0; i < 4; ++i) { v0[i] = gelu_tanh_f(v0[i]); v1[i] = gelu_tanh_f(v1[i]); } }
                    u32x4 w; w.x = cvt_pk_bf16(v0[0], v0[1]); w.y = cvt_pk_bf16(v0[2], v0[3]); w.z = cvt_pk_bf16(v1[0], v1[1]); w.w = cvt_pk_bf16(v1[2], v1[3]);
                    *(u32x4*)(rowp + bj * HALF) = w; }
            }
    }
};
struct EpiQK {
    bf16_t* Q; bf16_t* Kd; const float* qg; const float* kg; float qscale;
    DI void operator()(const Acc& acc, const Unit& u, int wr, int wc, int fr, int fq) const {
        const bool isq = u.pn < 4; const int hd = (4 * u.pn + wc) & 15;
        bf16_t* dst = isq ? Q : Kd; const float* gn = isq ? qg : kg; const float sc = isq ? qscale : 1.f;
        const int row0 = u.pm * BM + wr * 64 + fr;
#pragma unroll
        for (int ai = 0; ai < 2; ++ai)
#pragma unroll
            for (int m = 0; m < 4; ++m) {
                float ss = 0.f;
#pragma unroll
                for (int bj = 0; bj < 2; ++bj)
#pragma unroll
                    for (int n = 0; n < 2; ++n) { const f32x4 x = acc[ai][bj][m][n]; ss += (x[0] * x[0] + x[1] * x[1]) + (x[2] * x[2] + x[3] * x[3]); }
                ss += __shfl_xor(ss, 16); ss += __shfl_xor(ss, 32);
                const float rstd = rsqrtf(ss * (1.f / 64.f) + EPS);
                bf16_t* rowp = dst + (size_t)(row0 + ai * HALF + m * 16) * D + hd * 64 + 8 * fq;
#pragma unroll
                for (int bj = 0; bj < 2; ++bj) { const float rs2 = rstd * sc; const f32x4 v0 = acc[ai][bj][m][0] * rs2 * *(const f32x4*)(gn + 32 * bj + 8 * fq), v1 = acc[ai][bj][m][1] * rs2 * *(const f32x4*)(gn + 32 * bj + 8 * fq + 4);
                    u32x4 w; w.x = cvt_pk_bf16(v0[0], v0[1]); w.y = cvt_pk_bf16(v0[2], v0[3]); w.z = cvt_pk_bf16(v1[0], v1[1]); w.w = cvt_pk_bf16(v1[2], v1[3]);
                    *(u32x4*)(rowp + 32 * bj) = w; }
            }
    }
};
struct EpiPlain {
    bf16_t* O; int ldc;
    DI void operator()(const Acc& acc, const Unit& u, int wr, int wc, int fr, int fq) const {
        const int row0 = u.pm * BM + wr * 64 + fr, col0 = u.pn * BM + wc * 32 + 8 * fq;
#pragma unroll
        for (int ai = 0; ai < 2; ++ai)
#pragma unroll
            for (int m = 0; m < 4; ++m) {
                bf16_t* rowp = O + (size_t)(row0 + ai * HALF + m * 16) * ldc + col0;
#pragma unroll
                for (int bj = 0; bj < 2; ++bj) { const f32x4 v0 = acc[ai][bj][m][0], v1 = acc[ai][bj][m][1];
                    u32x4 w; w.x = cvt_pk_bf16(v0[0], v0[1]); w.y = cvt_pk_bf16(v0[2], v0[3]); w.z = cvt_pk_bf16(v1[0], v1[1]); w.w = cvt_pk_bf16(v1[2], v1[3]);
                    *(u32x4*)(rowp + bj * HALF) = w; }
            }
    }
};
}

struct TDesc { const float* src; int ld; int K; int N; bf16_t* dst; int ldt; int map; int rowadd; const float* kscale; };
DI void transpose_item(const TDesc& d, int k0, int n0, int drow, LAS float* scr, int lane) {
#pragma unroll 8
    for (int i = 0; i < 32; ++i) { const int kk = 2 * i + (lane >> 5); float v = d.src[(size_t)(k0 + kk) * d.ld + n0 + (lane & 31)]; if (d.kscale) v *= d.kscale[k0 + kk]; scr[kk * 33 + (lane & 31)] = v; }
    asm volatile("s_waitcnt lgkmcnt(0)" ::: "memory");
    const int c = lane & 7;
#pragma unroll
    for (int j = 0; j < 4; ++j) { const int n = (lane >> 3) + 8 * j; const LAS float* s = scr + (8 * c) * 33 + n;
        u32x4 o; o.x = pk2(s[0 * 33], s[1 * 33]); o.y = pk2(s[2 * 33], s[3 * 33]); o.z = pk2(s[4 * 33], s[5 * 33]); o.w = pk2(s[6 * 33], s[7 * 33]);
        *(u32x4*)(d.dst + (size_t)(drow + n) * d.ldt + k0 + 8 * c) = o; }
    asm volatile("s_waitcnt lgkmcnt(0)" ::: "memory");
}
DI void transpose_mat(const TDesc& d, int& base, int gw, int NGW, LAS float* scr, int lane) {
    const int nblk = d.N / 32, nitems = (d.K / 64) * nblk;
    int first = (gw - base) % NGW; if (first < 0) first += NGW;
    for (int it = first; it < nitems; it += NGW) {
        const int kb = it / nblk, nb = it % nblk, k0 = 64 * kb, n0 = 32 * nb;
        int drow;
        if (d.map == 0) drow = d.rowadd + n0;
        else if (d.map == 1) drow = 256 * (n0 >> 7) + (n0 & 127) + d.rowadd;
        else drow = 256 * (n0 >> 8) + 128 * ((n0 >> 5) & 1) + 32 * ((n0 >> 6) & 3);
        transpose_item(d, k0, n0, drow, scr, lane);
    }
    base = (base + nitems) % NGW;
}

struct Params { const float* in[23]; float* out; unsigned char* ws; };

DI void p0_phase(const Params& P, unsigned char* lds, int G) {
    int tid_ = threadIdx.x; asm volatile("" : "+v"(tid_));
    const int tid = tid_, lane = tid & 63, wave = tid >> 6;
    unsigned char* ws = P.ws;
    LAS float* scr = (LAS float*)((LAS unsigned char*)lds + wave * 9216);
    const int gw = blockIdx.x * NWAVES + wave, NGW = G * NWAVES;
    int base = 0;
    for (int f = 0; f < 4; ++f) {
        bf16_t* wgu = (bf16_t*)(ws + WS_WGU) + (size_t)f * 5632 * 1024;
        { TDesc d{P.in[5] + (size_t)f * D * FF, FF, D, FF, wgu, D, 1, 0, nullptr}; transpose_mat(d, base, gw, NGW, scr, lane); }
        { TDesc d{P.in[6] + (size_t)f * D * FF, FF, D, FF, wgu, D, 1, 128, nullptr}; transpose_mat(d, base, gw, NGW, scr, lane); }
        { TDesc d{P.in[7] + (size_t)f * FF * D, D, FF, D, (bf16_t*)(ws + WS_WDN) + (size_t)f * D * FF, FF, 0, 0, nullptr}; transpose_mat(d, base, gw, NGW, scr, lane); }
    }
    { TDesc d{P.in[8], INW, D, PW, (bf16_t*)(ws + WS_WIN), D, 0, 0, nullptr}; transpose_mat(d, base, gw, NGW, scr, lane); }
    { TDesc d{P.in[9], D, D, D, (bf16_t*)(ws + WS_WOUT1), D, 0, 0, nullptr}; transpose_mat(d, base, gw, NGW, scr, lane); }
    { TDesc d{P.in[9] + (size_t)D * D, D, D, D, (bf16_t*)(ws + WS_WOUT2), D, 0, 0, P.in[18]}; transpose_mat(d, base, gw, NGW, scr, lane); }
    { TDesc d{P.in[19], 3 * D, D, 2 * D, (bf16_t*)(ws + WS_WQK), D, 2, 0, nullptr}; transpose_mat(d, base, gw, NGW, scr, lane); }
    { TDesc d{P.in[19] + 2 * D, 3 * D, D, D, (bf16_t*)(ws + WS_WV), D, 0, 0, nullptr}; transpose_mat(d, base, gw, NGW, scr, lane); }
    { TDesc d{P.in[22], D, D, D, (bf16_t*)(ws + WS_WO), D, 0, 0, nullptr}; transpose_mat(d, base, gw, NGW, scr, lane); }
    float* rowss = (float*)(ws + WS_ROWSS);
    for (int i = blockIdx.x * NTHREADS + tid; i < T; i += G * NTHREADS) rowss[i] = 0.f;
    __syncthreads();
    float* sc = (float*)(lds + 81920);
    float* part = (float*)(lds + 114688);
    for (int i = tid; i < NB * D; i += NTHREADS) sc[i] = silu_f(P.in[1][i]);
    __syncthreads();
    float* mod = (float*)(ws + WS_MOD);
    for (int item = blockIdx.x; item < 288; item += G) {
        const int l = item / 144, n0 = (item % 144) * 64;
        const float* W = P.in[2] + (size_t)l * D * MODW + n0 + lane;
        float acc[8];
#pragma unroll
        for (int b = 0; b < 8; ++b) acc[b] = 0.f;
#pragma unroll 8
        for (int kk = 0; kk < 128; ++kk) { const int k = wave * 128 + kk; const float wv = W[(size_t)k * MODW];
#pragma unroll
            for (int b = 0; b < 8; ++b) acc[b] += sc[b * D + k] * wv; }
#pragma unroll
        for (int b = 0; b < 8; ++b) part[(wave * 8 + b) * 64 + lane] = acc[b];
        __syncthreads();
        { const int b = tid >> 6, col = tid & 63; float s = 0.f;
#pragma unroll
            for (int w = 0; w < 8; ++w) s += part[(w * 8 + b) * 64 + col];
            mod[(size_t)(l * 8 + b) * MODW + n0 + col] = s + P.in[3][(size_t)l * MODW + n0 + col]; }
        __syncthreads();
    }
}

template <bool PRE, bool MAIN, bool DT>
DI void norm_phase(const float* src, float* hdst, const float* gpre, bf16_t* xn, const float* g, const float* modl, float* dtraw, const float* w_in, unsigned char* lds, int G) {
    int tid_ = threadIdx.x; asm volatile("" : "+v"(tid_));
    const int tid = tid_, lane = tid & 63, wave = tid >> 6;
    const int gw = blockIdx.x * NWAVES + wave, NGW = G * NWAVES;
    float* wl = (float*)lds;
    if (DT) { for (int idx = tid; idx < 16384; idx += NTHREADS) { const int k = idx >> 4, hh = idx & 15; wl[hh * 1024 + k] = w_in[(size_t)k * INW + PW + hh]; } __syncthreads(); }
    for (int m = gw; m < T; m += NGW) {
        const f32x4* xr = (const f32x4*)(src + (size_t)m * D) + lane;
        f32x4 v[4]; float ss = 0.f;
#pragma unroll
        for (int j = 0; j < 4; ++j) { v[j] = xr[64 * j]; ss += (v[j][0] * v[j][0] + v[j][1] * v[j][1]) + (v[j][2] * v[j][2] + v[j][3] * v[j][3]); }
        if (PRE) {
            const float rstd = rsqrtf(wave_sum(ss) * (1.f / D) + EPS); ss = 0.f;
            f32x4* ho = (f32x4*)(hdst + (size_t)m * D) + lane;
#pragma unroll
            for (int j = 0; j < 4; ++j) { const f32x4 gp = ((const f32x4*)gpre)[lane + 64 * j]; v[j] = v[j] * rstd * gp; ho[64 * j] = v[j];
                ss += (v[j][0] * v[j][0] + v[j][1] * v[j][1]) + (v[j][2] * v[j][2] + v[j][3] * v[j][3]); }
        }
        if (MAIN) {
            const float rstd = rsqrtf(wave_sum(ss) * (1.f / D) + EPS);
            const int b = m >> 12;
            const f32x4* sh = (const f32x4*)(modl + (size_t)b * MODW) + lane; const f32x4* scl = (const f32x4*)(modl + (size_t)b * MODW + D) + lane;
            u32x2* o8 = (u32x2*)(xn + (size_t)m * D) + lane;
#pragma unroll
            for (int j = 0; j < 4; ++j) { const f32x4 gg = ((const f32x4*)g)[lane + 64 * j]; const f32x4 y = v[j] * rstd * gg * (scl[64 * j] + 1.f) + sh[64 * j]; v[j] = y;
                u32x2 w; w.x = pk2(y[0], y[1]); w.y = pk2(y[2], y[3]); o8[64 * j] = w; }
            if (DT) {
                float d[16];
#pragma unroll
                for (int hh = 0; hh < 16; ++hh) { float a = 0.f;
#pragma unroll
                    for (int j = 0; j < 4; ++j) { const f32x4 w4 = *(const f32x4*)(wl + hh * 1024 + 4 * (lane + 64 * j)); a += (v[j][0] * w4[0] + v[j][1] * w4[1]) + (v[j][2] * w4[2] + v[j][3] * w4[3]); }
                    d[hh] = a; if ((hh & 3) == 3) asm volatile("" ::: "memory"); }
                { const bool hb = (lane & 32) != 0;
#pragma unroll
                    for (int i = 0; i < 8; ++i) { const float keep = hb ? d[i + 8] : d[i], send = hb ? d[i] : d[i + 8]; d[i] = keep + __shfl_xor(send, 32); } }
                { const bool hb = (lane & 16) != 0;
#pragma unroll
                    for (int i = 0; i < 4; ++i) { const float keep = hb ? d[i + 4] : d[i], send = hb ? d[i] : d[i + 4]; d[i] = keep + __shfl_xor(send, 16); } }
                { const bool hb = (lane & 8) != 0;
#pragma unroll
                    for (int i = 0; i < 2; ++i) { const float keep = hb ? d[i + 2] : d[i], send = hb ? d[i] : d[i + 2]; d[i] = keep + __shfl_xor(send, 8); } }
                { const bool hb = (lane & 4) != 0; const float keep = hb ? d[1] : d[0], send = hb ? d[0] : d[1]; d[0] = keep + __shfl_xor(send, 4); }
                d[0] += __shfl_xor(d[0], 1); d[0] += __shfl_xor(d[0], 2);
                const int hh = ((lane >> 5) & 1) * 8 + ((lane >> 4) & 1) * 4 + ((lane >> 3) & 1) * 2 + ((lane >> 2) & 1);
                if ((lane & 3) == 0) dtraw[(size_t)m * 16 + hh] = d[0];
            }
        }
    }
}

DI void gmlp_item(int item, bf16_t* PROJ, const float* vg, const float* wsp, const float* bsp, unsigned char* lds) {
    int tid_ = threadIdx.x; asm volatile("" : "+v"(tid_));
    const int tid = tid_, lane = tid & 63, wave = tid >> 6, fr = lane & 15, fq = lane >> 4;
    const int b = item >> 8, blk = (item >> 3) & 31, g = item & 7;
    const int r0 = b * SEQ + blk * 128;
    bf16_t* vnT = (bf16_t*)lds;
    bf16_t* Wm = vnT + 128 * 136;
    {
        const int row = tid >> 2, q4 = tid & 3;
        const bf16_t* vp = PROJ + (size_t)(r0 + row) * PW + 1024 + g * 128 + q4 * 32;
        u32x4 raw[4];
#pragma unroll
        for (int i = 0; i < 4; ++i) raw[i] = *(const u32x4*)(vp + 8 * i);
        float f[32]; float ss = 0.f;
#pragma unroll
        for (int i = 0; i < 4; ++i)
#pragma unroll
            for (int e = 0; e < 4; ++e) { const unsigned u = raw[i][e]; f[8 * i + 2 * e] = bflo(u); f[8 * i + 2 * e + 1] = bfhi(u); }
#pragma unroll
        for (int i = 0; i < 32; ++i) ss += f[i] * f[i];
        ss += __shfl_xor(ss, 1); ss += __shfl_xor(ss, 2);
        const float rstd = rsqrtf(ss * (1.f / 128.f) + EPS);
        const float* gp = vg + g * 128 + q4 * 32;
#pragma unroll
        for (int i = 0; i < 32; ++i) vnT[(q4 * 32 + i) * 136 + row] = (bf16_t)f2bf(f[i] * rstd * gp[i]);
        const float* wp = wsp + ((size_t)g * 128 + row) * 128 + q4 * 32;
#pragma unroll
        for (int i = 0; i < 8; ++i) { f32x4 w4 = *(const f32x4*)(wp + 4 * i);
            if (row < 64 && q4 >= 2) w4 = (f32x4){0.f, 0.f, 0.f, 0.f};
            u32x2 o; o.x = pk2(w4[0], w4[1]); o.y = pk2(w4[2], w4[3]); *(u32x2*)(Wm + row * 136 + q4 * 32 + 4 * i) = o; }
    }
    __syncthreads();
    f32x4 acc[8];
#pragma unroll
    for (int ct = 0; ct < 8; ++ct) acc[ct] = (f32x4){0.f, 0.f, 0.f, 0.f};
    const int nks = (wave < 4) ? 2 : 4;
    for (int ks = 0; ks < nks; ++ks) {
        const bf16x8 af = *(const bf16x8*)(Wm + (16 * wave + fr) * 136 + 32 * ks + 8 * fq);
#pragma unroll
        for (int ct = 0; ct < 8; ++ct) { const bf16x8 bfr = *(const bf16x8*)(vnT + (16 * ct + fr) * 136 + 32 * ks + 8 * fq);
            acc[ct] = __builtin_amdgcn_mfma_f32_16x16x32_bf16(bfr, af, acc[ct], 0, 0, 0); }
    }
    {
        const int t = 16 * wave + fr; const float bias = bsp[g * 128 + t];
        bf16_t* up = PROJ + (size_t)(r0 + t) * PW + g * 128 + 4 * fq;
#pragma unroll
        for (int ct = 0; ct < 8; ++ct) { const u32x2 u2 = *(const u32x2*)(up + 16 * ct);
            u32x2 o; o.x = pk2(bflo(u2.x) * (acc[ct][0] + bias), bfhi(u2.x) * (acc[ct][1] + bias)); o.y = pk2(bflo(u2.y) * (acc[ct][2] + bias), bfhi(u2.y) * (acc[ct][3] + bias));
            *(u32x2*)(up + 16 * ct) = o; }
    }
    __syncthreads();
}

DI void ssd_item(int item, bf16_t* PROJ, bf16_t* ybase, int ldy, const float* dtraw, const float* conv_w, const float* conv_b, const float* dt_bias, const float* a_log, const float* dskip, float* rowss, unsigned char* lds) {
    int tid_ = threadIdx.x; asm volatile("" : "+v"(tid_));
    const int tid = tid_, lane = tid & 63, wave = tid >> 6, fr = lane & 15, fq = lane >> 4, r32 = lane & 31, hi = lane >> 5;
    const int b = item >> 4, hd = item & 15, g = hd >> 3;
    float* dtv = (float*)lds; float* csv = dtv + 4096;
    bf16_t* Cn = (bf16_t*)(lds + 32768);
    bf16_t* Bn = Cn + 64 * 136;
    bf16_t* BsT = Bn + 64 * 136;
    bf16_t* xsT = BsT + 128 * 72;
    bf16_t* Wl = xsT + 64 * 72;
    bf16_t* Hb = Wl + 64 * 72;
    const float Aneg = -__expf(a_log[hd]), dtb = dt_bias[hd], Dk = dskip[hd];
    for (int i = 0; i < 8; ++i) {
        const int t = (wave + 8 * i) * 64 + lane;
        const float raw = dtraw[(size_t)(b * SEQ + t) * 16 + hd] + dtb;
        const float dt = raw > 20.f ? raw : softplus_f(raw);
        float x = dt * Aneg;
#pragma unroll
        for (int o = 1; o < 64; o <<= 1) { const float y = __shfl_up(x, o); if (lane >= o) x += y; }
        dtv[t] = dt; csv[t] = x;
    }
    for (int idx = tid; idx < 64 * 136 / 2; idx += NTHREADS) ((unsigned*)Hb)[idx] = 0u;
    const bool active = tid < 320; const int cgp = tid % 40, rb = (tid / 40) & 7;
    const int col = cgp < 8 ? 3072 + hd * 64 + 8 * cgp : (cgp < 24 ? 4096 + g * 128 + 8 * (cgp - 8) : 4352 + g * 128 + 8 * (cgp - 24));
    const int ch0 = col - 3072;
    float* cwl = (float*)(lds + 121856);
    if (active) {
#pragma unroll
        for (int k = 0; k < 4; ++k)
#pragma unroll
            for (int i = 0; i < 8; ++i) cwl[k * 320 + cgp * 8 + i] = conv_w[k * 1536 + ch0 + i];
#pragma unroll
        for (int i = 0; i < 8; ++i) cwl[4 * 320 + cgp * 8 + i] = conv_b[ch0 + i];
    }
    f32x16 Hacc;
#pragma unroll
    for (int r = 0; r < 16; ++r) Hacc[r] = 0.f;
    u32x4 raw[11];
    const bf16_t* xcol = PROJ + (size_t)(b * SEQ) * PW + col;
#define SSD_LOAD_RAW(c) do { _Pragma("unroll") for (int i = 0; i < 11; ++i) { const int t = (c) * 64 + rb * 8 + i - 3; \
        raw[i] = (t >= 0) ? *(const u32x4*)(xcol + (size_t)t * PW) : (u32x4){0u, 0u, 0u, 0u}; } } while (0)
    if (active) SSD_LOAD_RAW(0);
    __syncthreads();
    const int tt = wave >> 1, half = wave & 1;
    for (int c = 0; c < 64; ++c) {
        const int tb = c * 64;
        if (active) {
            float o[8][8];
#pragma unroll
            for (int e = 0; e < 4; ++e) {
                const float* cwp = cwl + cgp * 8 + 2 * e;
                const float w00 = cwp[0], w01 = cwp[1], w10 = cwp[320], w11 = cwp[321], w20 = cwp[640], w21 = cwp[641], w30 = cwp[960], w31 = cwp[961], b0 = cwp[1280], b1 = cwp[1281];
#pragma unroll
                for (int i = 0; i < 8; ++i) {
                    const unsigned u0 = raw[i][e], u1 = raw[i + 1][e], u2 = raw[i + 2][e], u3 = raw[i + 3][e];
                    const float a0 = b0 + w00 * bflo(u0) + w10 * bflo(u1) + w20 * bflo(u2) + w30 * bflo(u3);
                    const float a1 = b1 + w01 * bfhi(u0) + w11 * bfhi(u1) + w21 * bfhi(u2) + w31 * bfhi(u3);
                    o[i][2 * e] = silu_f(a0); o[i][2 * e + 1] = silu_f(a1);
                }
            }
            if (cgp < 8) {
#pragma unroll
                for (int cc = 0; cc < 8; ++cc) { u32x4 w; w.x = pk2(o[0][cc], o[1][cc]); w.y = pk2(o[2][cc], o[3][cc]); w.z = pk2(o[4][cc], o[5][cc]); w.w = pk2(o[6][cc], o[7][cc]);
                    *(u32x4*)(xsT + (8 * cgp + cc) * 72 + rb * 8) = w; }
            } else if (cgp < 24) {
                const int n0 = 8 * (cgp - 8);
                const float cse = csv[tb + 63];
                float dte[8];
#pragma unroll
                for (int i = 0; i < 8; ++i) { const int t = tb + rb * 8 + i; dte[i] = __expf(cse - csv[t]) * dtv[t]; }
#pragma unroll
                for (int i = 0; i < 8; ++i) { u32x4 w; w.x = pk2(o[i][0], o[i][1]); w.y = pk2(o[i][2], o[i][3]); w.z = pk2(o[i][4], o[i][5]); w.w = pk2(o[i][6], o[i][7]);
                    *(u32x4*)(Bn + (rb * 8 + i) * 136 + n0) = w; }
#pragma unroll
                for (int cc = 0; cc < 8; ++cc) { u32x4 w; w.x = pk2(o[0][cc] * dte[0], o[1][cc] * dte[1]); w.y = pk2(o[2][cc] * dte[2], o[3][cc] * dte[3]);
                    w.z = pk2(o[4][cc] * dte[4], o[5][cc] * dte[5]); w.w = pk2(o[6][cc] * dte[6], o[7][cc] * dte[7]);
                    *(u32x4*)(BsT + (n0 + cc) * 72 + rb * 8) = w; }
            } else {
                const int n0 = 8 * (cgp - 24);
#pragma unroll
                for (int i = 0; i < 8; ++i) { u32x4 w; w.x = pk2(o[i][0], o[i][1]); w.y = pk2(o[i][2], o[i][3]); w.z = pk2(o[i][4], o[i][5]); w.w = pk2(o[i][6], o[i][7]);
                    *(u32x4*)(Cn + (rb * 8 + i) * 136 + n0) = w; }
            }
            if (c < 63) SSD_LOAD_RAW(c + 1);
        }
        __syncthreads();
        const int trow = 16 * tt + fr;
        bf16_t* zrow = PROJ + (size_t)(b * SEQ + tb + trow) * PW + 2048 + hd * 64 + 4 * fq;
        u32x2 zr[2];
#pragma unroll
        for (int p2 = 0; p2 < 2; ++p2) zr[p2] = *(const u32x2*)(zrow + 16 * (2 * half + p2));
        const float cs_t = csv[tb + trow];
        bf16x8 cf[4];
#pragma unroll
        for (int ks = 0; ks < 4; ++ks) cf[ks] = *(const bf16x8*)(Cn + trow * 136 + 32 * ks + 8 * fq);
#pragma unroll
        for (int s2 = 0; s2 < 2; ++s2) {
            const int st = 2 * half + s2;
            u32x2 w; w.x = 0u; w.y = 0u;
            if (st <= tt) {
                f32x4 ga = (f32x4){0.f, 0.f, 0.f, 0.f};
#pragma unroll
                for (int ks = 0; ks < 4; ++ks) { const bf16x8 bfr = *(const bf16x8*)(Bn + (16 * st + fr) * 136 + 32 * ks + 8 * fq);
                    ga = __builtin_amdgcn_mfma_f32_16x16x32_bf16(bfr, cf[ks], ga, 0, 0, 0); }
                float wv[4];
#pragma unroll
                for (int j = 0; j < 4; ++j) { const int s = 16 * st + 4 * fq + j;
                    float val = (s <= trow) ? ga[j] * __expf(cs_t - csv[tb + s]) * dtv[tb + s] : 0.f;
                    if (s == trow) val += Dk;
                    wv[j] = val; }
                w.x = pk2(wv[0], wv[1]); w.y = pk2(wv[2], wv[3]);
            }
            *(u32x2*)(Wl + trow * 72 + 16 * st + 4 * fq) = w;
        }
        f32x4 ya[2];
#pragma unroll
        for (int p2 = 0; p2 < 2; ++p2) { ya[p2] = (f32x4){0.f, 0.f, 0.f, 0.f}; const int pt = 2 * half + p2;
#pragma unroll
            for (int ks = 0; ks < 4; ++ks) { const bf16x8 hf = *(const bf16x8*)(Hb + (16 * pt + fr) * 136 + 32 * ks + 8 * fq);
                ya[p2] = __builtin_amdgcn_mfma_f32_16x16x32_bf16(hf, cf[ks], ya[p2], 0, 0, 0); }
            ya[p2] = ya[p2] * __expf(cs_t); }
        __syncthreads();
        {
            const int nks = (tt < 2) ? 1 : 2;
            for (int ks = 0; ks < nks; ++ks) { const bf16x8 wf = *(const bf16x8*)(Wl + trow * 72 + 32 * ks + 8 * fq);
#pragma unroll
                for (int p2 = 0; p2 < 2; ++p2) { const bf16x8 xf = *(const bf16x8*)(xsT + (16 * (2 * half + p2) + fr) * 72 + 32 * ks + 8 * fq);
                    ya[p2] = __builtin_amdgcn_mfma_f32_16x16x32_bf16(xf, wf, ya[p2], 0, 0, 0); } }
            float ss = 0.f;
#pragma unroll
            for (int p2 = 0; p2 < 2; ++p2) { const float z0 = bflo(zr[p2].x), z1 = bfhi(zr[p2].x), z2 = bflo(zr[p2].y), z3 = bfhi(zr[p2].y);
                const float y0 = ya[p2][0] * silu_f(z0), y1 = ya[p2][1] * silu_f(z1), y2 = ya[p2][2] * silu_f(z2), y3 = ya[p2][3] * silu_f(z3);
                ss += (y0 * y0 + y1 * y1) + (y2 * y2 + y3 * y3);
                u32x2 o; o.x = pk2(y0, y1); o.y = pk2(y2, y3); *(u32x2*)(ybase + (size_t)(b * SEQ + tb + trow) * ldy + hd * 64 + 4 * fq + 16 * (2 * half + p2)) = o; }
            ss += __shfl_xor(ss, 16); ss += __shfl_xor(ss, 32);
            if (fq == 0) atomicAdd(rowss + (size_t)(b * SEQ + tb + trow), ss);
            const int pp = wave >> 2, nn = wave & 3;
            const float cd = __expf(csv[tb + 63]);
#pragma unroll
            for (int r = 0; r < 16; ++r) Hacc[r] *= cd;
#pragma unroll
            for (int ks = 0; ks < 4; ++ks) { const bf16x8 bf = *(const bf16x8*)(BsT + (32 * nn + r32) * 72 + 16 * ks + 8 * hi);
                const bf16x8 xf = *(const bf16x8*)(xsT + (32 * pp + r32) * 72 + 16 * ks + 8 * hi);
                Hacc = __builtin_amdgcn_mfma_f32_32x32x16_bf16(bf, xf, Hacc, 0, 0, 0); }
#pragma unroll
            for (int r4 = 0; r4 < 4; ++r4) { u32x2 o; o.x = pk2(Hacc[4 * r4], Hacc[4 * r4 + 1]); o.y = pk2(Hacc[4 * r4 + 2], Hacc[4 * r4 + 3]);
                *(u32x2*)(Hb + (32 * pp + r32) * 136 + 32 * nn + 8 * r4 + 4 * hi) = o; }
        }
        __syncthreads();
    }
#undef SSD_LOAD_RAW
}

DI int pi32(int m) { return (m & ~12) | ((m & 4) << 1) | ((m & 8) >> 1); }
DI void attn_phase(const bf16_t* Q, const bf16_t* Kg, const bf16_t* Vt, bf16_t* O, unsigned char* lds, int G) {
    int tid_ = threadIdx.x; asm volatile("" : "+v"(tid_));
    const int tid = tid_, lane = tid & 63, wave = tid >> 6, r32 = lane & 31, hi = lane >> 5;
    const int key = tid >> 3, ch = tid & 7, stoff = key * 144 + ch * 16;
    const int krow = pi32(r32);
    for (int v = blockIdx.x; v < 256; v += G) {
        const int bh = v >> 1, par = v & 1, b = bh >> 4, hd = bh & 15;
        const bf16_t* kgp = Kg + (size_t)(b * SEQ + key) * D + hd * 64 + 8 * ch;
        const bf16_t* vgp = Vt + (size_t)(hd * 64 + key) * T + b * SEQ + 8 * ch;
        for (int ui = 0; ui < 8; ++ui) {
            const int s_ = par * 4 + (ui >> 1), qb = (ui & 1) ? 15 - s_ : s_;
            const int q0 = qb * 256, qw = q0 + 32 * wave, NT = 4 * qb + 4, tq = qw >> 6;
            const bf16_t* qp = Q + (size_t)(b * SEQ + qw + r32) * D + hd * 64 + 8 * hi;
            bf16x8 qf[4];
#pragma unroll
            for (int d0 = 0; d0 < 4; ++d0) qf[d0] = *(const bf16x8*)(qp + 16 * d0);
            f32x16 o0, o1;
#pragma unroll
            for (int r = 0; r < 16; ++r) { o0[r] = 0.f; o1[r] = 0.f; }
            float run = 0.f;
            u32x4 kr = *(const u32x4*)(kgp + (size_t)(NT - 1) * 64 * D), vr = *(const u32x4*)(vgp + (NT - 1) * 64);
            *(u32x4*)(lds + stoff) = kr; *(u32x4*)(lds + 9216 + stoff) = vr;
            __syncthreads();
            int buf = 0;
            for (int i = NT - 1; i >= 0; --i, buf ^= 1) {
                if (i > 0) { kr = *(const u32x4*)(kgp + (size_t)(i - 1) * 64 * D); vr = *(const u32x4*)(vgp + (i - 1) * 64); }
                if (i <= tq) {
                    const unsigned char* Kl = lds + buf * 18432; const unsigned char* Vl = Kl + 9216;
                    f32x16 p[2];
#pragma unroll
                    for (int kb = 0; kb < 2; ++kb) {
#pragma unroll
                        for (int r = 0; r < 16; ++r) p[kb][r] = 0.f;
#pragma unroll
                        for (int d0 = 0; d0 < 4; ++d0) { const bf16x8 kf = *(const bf16x8*)(Kl + (32 * kb + krow) * 144 + (16 * d0 + 8 * hi) * 2);
                            p[kb] = __builtin_amdgcn_mfma_f32_32x32x16_bf16(kf, qf[d0], p[kb], 0, 0, 0); }
                    }
                    const bool masked = (i == tq);
                    float lk[2][16];
#pragma unroll
                    for (int kb = 0; kb < 2; ++kb)
#pragma unroll
                        for (int r = 0; r < 16; ++r) {
                            const float z = p[kb][r];
                            const float sp = fmaxf(z, 0.f) + lg2(1.f + ex2(-fabsf(z)));
                            float lkv = -sp, lb = z - sp;
                            if (masked) { const int ka = 64 * i + 32 * kb + 16 * (r >> 3) + 8 * hi + (r & 7); const bool valid = ka < qw + r32; lkv = valid ? lkv : 0.f; lb = valid ? lb : -INFINITY; }
                            lk[kb][r] = lkv; p[kb][r] = lb;
                        }
                    float glo[2][2], ghi[2][2];
#pragma unroll
                    for (int kb = 0; kb < 2; ++kb)
#pragma unroll
                        for (int s = 0; s < 2; ++s) { float gs = 0.f;
#pragma unroll
                            for (int j = 0; j < 8; ++j) gs += lk[kb][8 * s + j];
                            auto rr = __builtin_amdgcn_permlane32_swap(__float_as_uint(gs), __float_as_uint(gs), false, false);
                            glo[kb][s] = __uint_as_float(rr[0]); ghi[kb][s] = __uint_as_float(rr[1]); }
                    float basev = run;
#pragma unroll
                    for (int kb = 1; kb >= 0; --kb)
#pragma unroll
                        for (int s = 1; s >= 0; --s) {
                            float a = basev + (hi == 0 ? ghi[kb][s] : 0.f);
#pragma unroll
                            for (int j = 7; j >= 0; --j) { const float w = ex2(p[kb][8 * s + j] + a); a += lk[kb][8 * s + j]; p[kb][8 * s + j] = w; }
                            basev += glo[kb][s] + ghi[kb][s];
                        }
                    run = basev;
#pragma unroll
                    for (int kb = 0; kb < 2; ++kb)
#pragma unroll
                        for (int s = 0; s < 2; ++s) {
                            u32x4 pw; pw.x = cvt_pk_bf16(p[kb][8 * s + 0], p[kb][8 * s + 1]); pw.y = cvt_pk_bf16(p[kb][8 * s + 2], p[kb][8 * s + 3]);
                            pw.z = cvt_pk_bf16(p[kb][8 * s + 4], p[kb][8 * s + 5]); pw.w = cvt_pk_bf16(p[kb][8 * s + 6], p[kb][8 * s + 7]);
                            const bf16x8 pa = __builtin_bit_cast(bf16x8, pw);
                            const bf16x8 v0 = *(const bf16x8*)(Vl + (r32) * 144 + (32 * kb + 16 * s + 8 * hi) * 2);
                            const bf16x8 v1 = *(const bf16x8*)(Vl + (32 + r32) * 144 + (32 * kb + 16 * s + 8 * hi) * 2);
                            o0 = __builtin_amdgcn_mfma_f32_32x32x16_bf16(pa, v0, o0, 0, 0, 0);
                            o1 = __builtin_amdgcn_mfma_f32_32x32x16_bf16(pa, v1, o1, 0, 0, 0);
                        }
                }
                if (i > 0) { *(u32x4*)(lds + (buf ^ 1) * 18432 + stoff) = kr; *(u32x4*)(lds + (buf ^ 1) * 18432 + 9216 + stoff) = vr; }
                __syncthreads();
            }
            bf16_t* op = O + (size_t)(b * SEQ + qw) * D + hd * 64 + r32;
#pragma unroll
            for (int r = 0; r < 16; ++r) { const int qrow = (r & 3) + 8 * (r >> 2) + 4 * hi;
                op[(size_t)qrow * D] = (bf16_t)f2bf(o0[r]); op[(size_t)qrow * D + 32] = (bf16_t)f2bf(o1[r]); }
        }
    }
}


#define XB_TMO      128
#define XB_XCNT(j)  (256  + 64 * (j))
#define XB_XSUB(j)  (1280 + 64 * (j))
#define XB_XGEN(j)  (2304 + 64 * (j))
#define XB_TOP      3328
#define XB_TOPGEN   3392
#define XCD_BAR_WORDS 3456
#define XB_SPIN_CAP (1u << 18)
DI unsigned xb_ld(unsigned* p)              { return __hip_atomic_load(p, __ATOMIC_RELAXED, __HIP_MEMORY_SCOPE_AGENT); }
DI unsigned xb_add(unsigned* p, unsigned v) { return __hip_atomic_fetch_add(p, v, __ATOMIC_RELAXED, __HIP_MEMORY_SCOPE_AGENT); }
DI unsigned xb_xcc_id() { return (unsigned)__builtin_amdgcn_s_getreg((3 << 11) | 20) & 0xFu; }
#define XB_SPIN(cond, bar) do { unsigned _sp = 0; while (cond) { __builtin_amdgcn_s_sleep(1); \
    if ((++_sp & 255u) == 0u) { if (xb_ld(&(bar)[XB_TMO])) break; if (_sp > XB_SPIN_CAP) { atomicAdd(&(bar)[XB_TMO], 1u); break; } } } } while (0)
struct XcdBarrier { unsigned* bar; unsigned x; volatile LAS unsigned* st; };
DI XcdBarrier xcd_barrier_post(unsigned* bar, volatile LAS unsigned* st) {
    XcdBarrier b; b.bar = bar; b.x = xb_xcc_id(); b.st = st;
    if (threadIdx.x == 0) (void)xb_add(&bar[XB_XCNT(b.x)], 1u);
    return b;
}
DI void xcd_barrier_complete(unsigned* bar, unsigned x, unsigned& nloc, unsigned& nx) {
    const unsigned G = gridDim.x * gridDim.y * gridDim.z;
    unsigned sum, cnt, mine, sp = 0u;
    for (;;) {
        sum = 0u; cnt = 0u; mine = 0u;
#pragma unroll
        for (unsigned j = 0; j < 16; ++j) { const unsigned c = xb_ld(&bar[XB_XCNT(j)]); sum += c; cnt += (c > 0u) ? 1u : 0u; mine = (j == x) ? c : mine; }
        if (sum == G) break;
        __builtin_amdgcn_s_sleep(1);
        if ((++sp & 255u) == 0u) { if (xb_ld(&bar[XB_TMO])) break; if (sp > XB_SPIN_CAP) { atomicAdd(&bar[XB_TMO], 1u); break; } }
    }
    nloc = mine > 0u ? mine : 1u; nx = cnt > 0u ? cnt : 1u;
}
DI void xcd_barrier(const XcdBarrier& b) {
    asm volatile("s_waitcnt vmcnt(0)" ::: "memory");
    __syncthreads();
    if (threadIdx.x == 0) {
        unsigned* bar = b.bar;
        __builtin_amdgcn_s_waitcnt(0);
        unsigned nloc = b.st[0], nx = b.st[1];
        if (nloc == 0u) { xcd_barrier_complete(bar, b.x, nloc, nx); b.st[0] = nloc; b.st[1] = nx; }
        const unsigned old = xb_add(&bar[XB_XSUB(b.x)], 1u);
        const unsigned gen = old / nloc;
        if (old + 1u == (gen + 1u) * nloc) {
            __builtin_amdgcn_fence(__ATOMIC_RELEASE, "agent");
            asm volatile("s_waitcnt vmcnt(0)" ::: "memory");
            const unsigned og = xb_add(&bar[XB_TOP], 1u);
            const unsigned tg = og / nx;
            if (og + 1u == (tg + 1u) * nx) xb_add(&bar[XB_TOPGEN], 1u);
            else XB_SPIN(xb_ld(&bar[XB_TOPGEN]) == tg, bar);
            __builtin_amdgcn_fence(__ATOMIC_ACQUIRE, "agent");
            xb_add(&bar[XB_XGEN(b.x)], 1u);
            asm volatile("s_waitcnt vmcnt(0)" ::: "memory");
        } else {
            XB_SPIN(xb_ld(&bar[XB_XGEN(b.x)]) == gen, bar);
            __builtin_amdgcn_fence(__ATOMIC_ACQUIRE, "agent");
            asm volatile("s_waitcnt vmcnt(0)" ::: "memory");
        }
    }
    __syncthreads();
}
#ifndef PM
#define PM 0xFFFF
#endif
#define PH(bit) if constexpr ((PM >> (bit)) & 1)
#ifdef USE_CG_SYNC
#define GSYNC() grid.sync()
#else
#define GSYNC() xcd_barrier(xbar)
#endif
__global__ void __launch_bounds__(NTHREADS, 2) fwd_megakernel(Params P) {
    extern __shared__ __attribute__((aligned(16))) unsigned char lds[];
    cg::grid_group grid = cg::this_grid();
    const int G = gridDim.x, bid = blockIdx.x;
    unsigned char* ws = P.ws;
    LAS unsigned char* ldsl = (LAS unsigned char*)lds;
    float* mod = (float*)(ws + WS_MOD);
    float* rowss = (float*)(ws + WS_ROWSS);
    float* dtraw = (float*)(ws + WS_DT);
    bf16_t* XN = (bf16_t*)(ws + WS_XN);
    bf16_t* BIG = (bf16_t*)(ws + WS_BIG);
    float* H = P.out;
    const float* normg = P.in[4];

    unsigned* barw = (unsigned*)(ws + WS_ROWSS + 512 * 1024);
    if (bid == 0) for (int i = threadIdx.x; i < XCD_BAR_WORDS; i += NTHREADS) barw[i] = 0u;
    volatile LAS unsigned* xst = (volatile LAS unsigned*)(ldsl + 147456 - 64);
    if (threadIdx.x < 2) xst[threadIdx.x] = 0u;
    PH(0) p0_phase(P, lds, G);
#ifdef REP_P0
    __syncthreads(); p0_phase(P, lds, G);
#endif
    grid.sync();
    XcdBarrier xbar = xcd_barrier_post(barw, xst);

    for (int l = 0; l < 2; ++l) {
        const float* modl = mod + (size_t)l * 8 * MODW;
        PH(1) { if (l == 0) { norm_phase<false, true, false>(P.in[0], nullptr, nullptr, XN, normg + (l * 4 + 0) * D, modl + 0 * 3072, nullptr, nullptr, lds, G);
#ifdef REP_N1
            __syncthreads(); norm_phase<false, true, false>(P.in[0], nullptr, nullptr, XN, normg + (l * 4 + 0) * D, modl + 0 * 3072, nullptr, nullptr, lds, G);
#endif
        }
        else        norm_phase<true, true, false>(H, H, normg + (0 * 4 + 3) * D, XN, normg + (l * 4 + 0) * D, modl + 0 * 3072, nullptr, nullptr, lds, G); }
        GSYNC();
        for (int i = 0; i < 2; ++i) {
            const int f = l * 2 + i;
            if (i == 1) { PH(1) norm_phase<false, true, false>(H, nullptr, nullptr, XN, normg + (l * 4 + 2) * D, modl + 2 * 3072, nullptr, nullptr, lds, G); GSYNC(); }
            PH(2) { pg8::Gemm g{XN, (const bf16_t*)(ws + WS_WGU) + (size_t)f * 5632 * 1024, T, 5632, D, D}; pg8::StaticOrder S; S.init(T, 5632, G, bid);
              pg8::EpiSwiGLU E{BIG}; pg8::gemm_phase(ldsl, g, S, E); }
#ifdef REP_GU
            if (f == 0) { __syncthreads(); pg8::Gemm g{XN, (const bf16_t*)(ws + WS_WGU) + (size_t)f * 5632 * 1024, T, 5632, D, D}; pg8::StaticOrder S; S.init(T, 5632, G, bid);
              pg8::EpiSwiGLU E{BIG}; pg8::gemm_phase(ldsl, g, S, E); }
#endif
            GSYNC();
            PH(3) { pg8::Gemm g{BIG, (const bf16_t*)(ws + WS_WDN) + (size_t)f * D * FF, T, D, FF, FF}; pg8::StaticOrder S; S.init(T, D, G, bid);
              pg8::EpiResid<1, false> E{(l == 0 && i == 0) ? P.in[0] : H, H, modl + (i == 0 ? 0 : 2) * 3072 + 2048, rowss}; pg8::gemm_phase(ldsl, g, S, E); }
            GSYNC();
            if (i == 0) {
                if (l == 0) {
                    PH(1) norm_phase<false, true, true>(H, nullptr, nullptr, XN, normg + (l * 4 + 1) * D, modl + 1 * 3072, dtraw, P.in[8], lds, G);
                    GSYNC();
                    PH(4) { pg8::Gemm g{XN, (const bf16_t*)(ws + WS_WIN), T, PW, D, D}; pg8::StaticOrder S; S.init(T, PW, G, bid);
                      pg8::EpiProj E{BIG}; pg8::gemm_phase(ldsl, g, S, E); }
                    GSYNC();
                    if (G >= 256) {
#ifdef REP_SSD
                        if (bid < 128) { ssd_item(bid, BIG, XN, D, dtraw, P.in[13], P.in[14], P.in[15], P.in[16], P.in[17], rowss + 65536, lds); __syncthreads(); }
#endif
                        if (bid < 128) { PH(5) ssd_item(bid, BIG, BIG + 2048, PW, dtraw, P.in[13], P.in[14], P.in[15], P.in[16], P.in[17], rowss, lds); }
                        else { PH(6) for (int it = bid - 128; it < 2048; it += G - 128) gmlp_item(it, BIG, P.in[10], P.in[11], P.in[12], lds); }
                    } else {
                        PH(5) for (int it = bid; it < 128; it += G) { ssd_item(it, BIG, BIG + 2048, PW, dtraw, P.in[13], P.in[14], P.in[15], P.in[16], P.in[17], rowss, lds); __syncthreads(); }
                        PH(6) for (int it = bid; it < 2048; it += G) gmlp_item(it, BIG, P.in[10], P.in[11], P.in[12], lds);
                    }
                    GSYNC();
                    PH(7) { pg8::Gemm g{BIG, (const bf16_t*)(ws + WS_WOUT1), T, D, D, PW}; pg8::StaticOrder S; S.init(T, D, G, bid);
                      pg8::EpiResid<2, false> E{H, H, modl + 1 * 3072 + 2048, rowss}; pg8::gemm_phase(ldsl, g, S, E); }
                    PH(7) { pg8::Gemm g{BIG + 2048, (const bf16_t*)(ws + WS_WOUT2), T, D, D, PW}; pg8::StaticOrder S; S.init(T, D, G, bid);
                      pg8::EpiResid<2, true> E{H, H, modl + 1 * 3072 + 2048, rowss}; pg8::gemm_phase(ldsl, g, S, E); }
                    GSYNC();
                } else {
                    PH(1) norm_phase<false, true, false>(H, nullptr, nullptr, XN, normg + (l * 4 + 1) * D, modl + 1 * 3072, nullptr, nullptr, lds, G);
                    GSYNC();
                    PH(8) { pg8::Gemm g{XN, (const bf16_t*)(ws + WS_WQK), T, 2 * D, D, D}; pg8::StaticOrder S; S.init(T, 2 * D, G, bid);
                      pg8::EpiQK E{(bf16_t*)(ws + WS_Q), (bf16_t*)(ws + WS_K), P.in[20], P.in[21], 0.125f * LOG2E}; pg8::gemm_phase(ldsl, g, S, E); }
                    PH(8) { pg8::Gemm g{(const bf16_t*)(ws + WS_WV), XN, D, T, D, D}; pg8::StaticOrder S; S.init(D, T, G, bid);
                      pg8::EpiPlain E{(bf16_t*)(ws + WS_VT), T}; pg8::gemm_phase(ldsl, g, S, E); }
                    GSYNC();
                    PH(9) attn_phase((const bf16_t*)(ws + WS_Q), (const bf16_t*)(ws + WS_K), (const bf16_t*)(ws + WS_VT), XN, lds, G);
#ifdef REP_ATT
                    __syncthreads(); attn_phase((const bf16_t*)(ws + WS_Q), (const bf16_t*)(ws + WS_K), (const bf16_t*)(ws + WS_VT), XN, lds, G);
#endif
                    GSYNC();
                    PH(10) { pg8::Gemm g{XN, (const bf16_t*)(ws + WS_WO), T, D, D, D}; pg8::StaticOrder S; S.init(T, D, G, bid);
                      pg8::EpiResid<2, false> E{H, H, modl + 1 * 3072 + 2048, rowss}; pg8::gemm_phase(ldsl, g, S, E); }
                    GSYNC();
                }
            }
        }
    }
#ifdef REP_SYNC
    for (int r = 0; r < 20; ++r) grid.sync();
#endif
    PH(1) norm_phase<true, false, false>(H, H, normg + (1 * 4 + 3) * D, nullptr, nullptr, nullptr, nullptr, nullptr, lds, G);
}

extern "C" void kernel_launch(void* const* d_in, const int* in_sizes, int n_in, void* d_out, int out_size, void* d_ws, size_t ws_size, hipStream_t stream) {
    static int grid = 0;
    if (grid == 0) {
        if (n_in != 23 || out_size != T * D || ws_size < WS_END) { fprintf(stderr, "kernel_launch: unexpected shapes (n_in %d out %d ws %zu)\n", n_in, out_size, ws_size); grid = -1; return; }
        int dev = 0, cus = 0, per_cu = 0;
        hipGetDevice(&dev);
        hipDeviceGetAttribute(&cus, hipDeviceAttributeMultiprocessorCount, dev);
        hipFuncSetAttribute((const void*)fwd_megakernel, hipFuncAttributeMaxDynamicSharedMemorySize, LDS_BYTES);
        hipOccupancyMaxActiveBlocksPerMultiprocessor(&per_cu, (const void*)fwd_megakernel, NTHREADS, LDS_BYTES);
        if (per_cu < 1) per_cu = 1;
        grid = cus * per_cu;
        (void)hipGetLastError();
    }
    if (grid < 0) return;
    Params p{};
    for (int i = 0; i < 23; ++i) p.in[i] = (const float*)d_in[i];
    p.out = (float*)d_out; p.ws = (unsigned char*)d_ws;
    void* args[] = {&p};
    hipError_t e = hipLaunchCooperativeKernel((const void*)fwd_megakernel, dim3(grid), dim3(NTHREADS), args, LDS_BYTES, stream);
    if (e != hipSuccess) fprintf(stderr, "cooperative launch failed: %s (grid %d)\n", hipGetErrorString(e), grid);
}
```

```cpp
#include <hip/hip_runtime.h>
#include <hip/hip_cooperative_groups.h>
#include <cstdio>
#include <cstdint>
namespace cg = cooperative_groups;

#define DI __device__ __forceinline__
#define LAS __attribute__((address_space(3)))
typedef unsigned short bf16_t;
typedef short bf16x8 __attribute__((ext_vector_type(8)));
typedef float f32x4 __attribute__((ext_vector_type(4)));
typedef float f32x16 __attribute__((ext_vector_type(16)));
typedef unsigned u32x4 __attribute__((ext_vector_type(4)));
typedef unsigned u32x2 __attribute__((ext_vector_type(2)));

constexpr int T = 32768, D = 1024, FF = 2816, SEQ = 4096, NB = 8;
constexpr int INW = 4624, PW = 4608;
constexpr int MODW = 9216;
constexpr float EPS = 1e-6f;
constexpr float LOG2E = 1.4426950408889634f, LN2 = 0.6931471805599453f;
constexpr int NTHREADS = 512, NWAVES = 8;
constexpr int LDS_BYTES = 147456;

constexpr size_t MiB = 1u << 20;
constexpr size_t WS_MOD = 0;
constexpr size_t WS_ROWSS = 1 * MiB;
constexpr size_t WS_DT = 2 * MiB;
constexpr size_t WS_WGU = 4 * MiB;
constexpr size_t WS_WDN = 48 * MiB;
constexpr size_t WS_WIN = 70 * MiB;
constexpr size_t WS_WOUT1 = 79 * MiB, WS_WOUT2 = 81 * MiB;
constexpr size_t WS_WQK = 83 * MiB;
constexpr size_t WS_WV = 87 * MiB, WS_WO = 89 * MiB;
constexpr size_t WS_XN = 92 * MiB;
constexpr size_t WS_BIG = 156 * MiB;
constexpr size_t WS_Q = WS_BIG, WS_K = WS_BIG + 64 * MiB, WS_VT = WS_BIG + 128 * MiB;
constexpr size_t WS_END = 444 * MiB;

DI unsigned f2bf(float f) { unsigned u = __builtin_bit_cast(unsigned, f); return (u + 0x7fffu + ((u >> 16) & 1u)) >> 16; }
typedef float f32x2_t __attribute__((ext_vector_type(2))); typedef __bf16 bf16x2_t __attribute__((ext_vector_type(2)));
DI unsigned cvt_pk_bf16(float lo, float hi) { f32x2_t v = {lo, hi}; bf16x2_t b = __builtin_convertvector(v, bf16x2_t); return __builtin_bit_cast(unsigned, b); }
DI unsigned pk2(float lo, float hi) { return cvt_pk_bf16(lo, hi); }
DI float bflo(unsigned u) { return __uint_as_float(u << 16); }
DI float bfhi(unsigned u) { return __uint_as_float(u & 0xffff0000u); }
DI float ex2(float x) { return __builtin_amdgcn_exp2f(x); }
DI float lg2(float x) { return __builtin_amdgcn_logf(x); }
DI float rcpf_(float x) { return __builtin_amdgcn_rcpf(x); }
DI float silu_f(float x) { return x * rcpf_(1.f + ex2(-x * LOG2E)); }
DI float gelu_tanh_f(float x) { const float u = 0.7978845608028654f * (x + 0.044715f * x * x * x); return x * rcpf_(1.f + ex2(-2.f * LOG2E * u)); }
DI float softplus_f(float x) { return fmaxf(x, 0.f) + LN2 * lg2(1.f + ex2(-fabsf(x) * LOG2E)); }
DI float wave_sum(float v) {
#pragma unroll
    for (int o = 1; o < 64; o <<= 1) v += __shfl_xor(v, o);
    return v;
}

namespace pg8 {
constexpr int BM = 256, BK = 64, HALF = 128, HTB = HALF * BK * 2, STAGE_BYTES = 8 * HTB, NXCD = 8, WGM = 8;
DI int lds_byte(int r, int c) { const int st = (r >> 4) * 2 + (c >> 5), rr = r & 15, cc = c & 31, ob = rr * 64 + cc * 2; return st * 1024 + (ob ^ (((ob >> 9) & 1) << 5)); }
DI void stage_rc(int b, int& R, int& C) { const int st = b / 1024, sb = b % 1024, swz = sb ^ (((sb >> 9) & 1) << 5); R = (st >> 1) * 16 + swz / 64; C = (st & 1) * 32 + (swz % 64) / 2; }
DI int perm32(int rho) { const int n = rho >> 4, i = rho & 15; return 8 * (i >> 2) + 4 * n + (i & 3); }

struct Unit { int pm, pn; };
struct Gemm { const bf16_t* A; const bf16_t* Bt; int M, N, K, lda; };

struct StaticOrder {
    int nM, nN, nwg, G, c;
    DI void init(int M, int N, int G_, int c_) { nM = M / BM; nN = N / BM; nwg = nM * nN; G = G_; c = c_; }
    DI bool next(int i, Unit& u) const {
        const long L = (long)i * G + c; if (L >= nwg) return false;
        int wgid = (int)L; { const int q = nwg / NXCD, r = nwg % NXCD, xcd = wgid % NXCD, off = wgid / NXCD; wgid = (xcd < r ? xcd * (q + 1) : r * (q + 1) + (xcd - r) * q) + off; }
        const int nig = WGM * nN, gid = wgid / nig, fm = gid * WGM, gsz = (nM - fm) < WGM ? (nM - fm) : WGM;
        u.pm = fm + ((wgid % nig) % gsz); u.pn = (wgid % nig) / gsz; return true;
    }
};

template <class Epi>
DI void gemm_phase(LAS unsigned char* lds, const Gemm g, const StaticOrder& S, const Epi& E) {
    int tid_ = threadIdx.x; asm volatile("" : "+v"(tid_));
    const int tid = tid_, wid = __builtin_amdgcn_readfirstlane(tid >> 6), lane = tid & 63, wr = wid >> 2, wc = wid & 3, fr = lane & 15, fq = lane >> 4;
    const int K = g.K, nt = K / BK, lda = g.lda;
    unsigned voffA[2], voffB[2];
#pragma unroll
    for (int i = 0; i < 2; ++i) { int R, C; stage_rc(tid * 16 + i * 8192, R, C); const int Rb = (R & ~31) + perm32(R & 31);
        voffA[i] = (unsigned)(R * lda + C) * 2u; voffB[i] = (unsigned)(Rb * K + C) * 2u; }
    const size_t kstep = (size_t)(BK * 2);
    const size_t hstepA = (size_t)HALF * lda * 2, hstepB = (size_t)HALF * K * 2;
    const size_t tstepA = 2 * hstepA, tstepB = 2 * hstepB;
    const unsigned ldsw = (unsigned)wid * 1024u;
    const int aoff = lds_byte(wr * 64 + fr, fq * 8), boff = lds_byte(wc * 32 + fr, fq * 8);
#define PG8_SA(b, h) (((b) * 2 + (h)) * HTB)
#define PG8_SB(b, h) ((4 + (b) * 2 + (h)) * HTB)
#define PG8_STAGE(bufoff, gbase, voff) do { _Pragma("unroll") for (int _i = 0; _i < 2; ++_i) \
        __builtin_amdgcn_global_load_lds((const unsigned*)((const char*)(gbase) + (voff)[_i]), (LAS unsigned*)(lds + (bufoff) + ldsw + _i * 8192), 16, 0, 0); } while (0)
#define PG8_LDA(dst, b, h) do { _Pragma("unroll") for (int m = 0; m < 4; ++m) _Pragma("unroll") for (int k = 0; k < 2; ++k) dst[m][k] = *(const LAS bf16x8*)(lds + PG8_SA(b, h) + aoff + m * 2048 + k * 1024); } while (0)
#define PG8_LDB(dst, b, h) do { _Pragma("unroll") for (int n = 0; n < 2; ++n) _Pragma("unroll") for (int k = 0; k < 2; ++k) dst[n][k] = *(const LAS bf16x8*)(lds + PG8_SB(b, h) + boff + n * 2048 + k * 1024); } while (0)
#define PG8_MMA(ai, bj, At, Bt) do { __builtin_amdgcn_s_setprio(1); _Pragma("unroll") for (int m = 0; m < 4; ++m) _Pragma("unroll") for (int n = 0; n < 2; ++n) _Pragma("unroll") for (int k = 0; k < 2; ++k) \
        acc[ai][bj][m][n] = __builtin_amdgcn_mfma_f32_16x16x32_bf16(Bt[n][k], At[m][k], acc[ai][bj][m][n], 0, 0, 0); __builtin_amdgcn_s_setprio(0); } while (0)
#define PG8_WAIT_V(n) asm volatile("s_waitcnt vmcnt(" #n ")" ::: "memory")
#define PG8_WAIT_L(n) asm volatile("s_waitcnt lgkmcnt(" #n ")" ::: "memory")
#define PG8_BAR __builtin_amdgcn_s_barrier()
#define PG8_SCHED __builtin_amdgcn_sched_barrier(0)
    Unit cur, nxt; int ui = 0;
    if (!S.next(0, cur)) return;
    f32x4 acc[2][2][4][2];
#pragma unroll
    for (int a = 0; a < 2; ++a)
#pragma unroll
        for (int b = 0; b < 2; ++b)
#pragma unroll
            for (int m = 0; m < 4; ++m)
#pragma unroll
                for (int n = 0; n < 2; ++n) acc[a][b][m][n] = (f32x4){0.f, 0.f, 0.f, 0.f};
    bf16x8 At[4][2], B0[2][2], B1[2][2];
    const char* cA = (const char*)g.A + (size_t)cur.pm * tstepA; const char* cB = (const char*)g.Bt + (size_t)cur.pn * tstepB;
    PG8_STAGE(PG8_SB(0, 0), cB, voffB); PG8_STAGE(PG8_SB(0, 1), cB + hstepB, voffB); PG8_STAGE(PG8_SA(0, 0), cA, voffA); PG8_STAGE(PG8_SA(0, 1), cA + hstepA, voffA);
    if (wr == 1) PG8_BAR;
    PG8_WAIT_V(2); PG8_BAR;
    PG8_STAGE(PG8_SB(1, 0), cB + kstep, voffB); PG8_STAGE(PG8_SA(1, 0), cA + kstep, voffA); PG8_STAGE(PG8_SB(1, 1), cB + hstepB + kstep, voffB);
    PG8_WAIT_V(6); PG8_BAR;
    for (;;) {
        const bool has_next = S.next(ui + 1, nxt);
        const char* nA = has_next ? (const char*)g.A + (size_t)nxt.pm * tstepA : cA; const char* nB = has_next ? (const char*)g.Bt + (size_t)nxt.pn * tstepB : cB;
        for (int t = 0; t < nt; t += 2) {
            const bool last = (t == nt - 2);
            const char* a1 = cA + (size_t)(t + 1) * kstep;
            const char* a2 = last ? nA : cA + (size_t)(t + 2) * kstep; const char* b2 = last ? nB : cB + (size_t)(t + 2) * kstep;
            const char* a3 = a2 + kstep; const char* b3 = b2 + kstep;
            PG8_LDB(B0, 0, 0); PG8_LDB(B1, 0, 1); PG8_SCHED; PG8_LDA(At, 0, 0); PG8_STAGE(PG8_SA(1, 1), a1 + hstepA, voffA);
            PG8_WAIT_V(8); PG8_WAIT_L(0); PG8_BAR; PG8_MMA(0, 0, At, B0); PG8_MMA(0, 1, At, B1); PG8_BAR; PG8_SCHED;
            PG8_LDA(At, 0, 1); PG8_STAGE(PG8_SB(0, 0), b2, voffB); PG8_STAGE(PG8_SB(0, 1), b2 + hstepB, voffB); PG8_STAGE(PG8_SA(0, 0), a2, voffA);
            PG8_WAIT_V(8); PG8_WAIT_L(0); PG8_BAR; PG8_MMA(1, 0, At, B0); PG8_MMA(1, 1, At, B1); PG8_BAR; PG8_SCHED;
            PG8_LDB(B0, 1, 0); PG8_LDB(B1, 1, 1); PG8_SCHED; PG8_LDA(At, 1, 0); PG8_STAGE(PG8_SA(0, 1), a2 + hstepA, voffA);
            PG8_WAIT_V(8); PG8_WAIT_L(0); PG8_BAR; PG8_MMA(0, 0, At, B0); PG8_MMA(0, 1, At, B1); PG8_BAR; PG8_SCHED;
            PG8_LDA(At, 1, 1); PG8_STAGE(PG8_SB(1, 0), b3, voffB); PG8_STAGE(PG8_SB(1, 1), b3 + hstepB, voffB); PG8_STAGE(PG8_SA(1, 0), a3, voffA);
            PG8_WAIT_V(8); PG8_WAIT_L(0); PG8_BAR; PG8_MMA(1, 0, At, B0); PG8_MMA(1, 1, At, B1); PG8_BAR; PG8_SCHED;
        }
        if (wr == 0) PG8_BAR;
        E(acc, cur, wr, wc, fr, fq);
        if (!has_next) break;
#pragma unroll
        for (int a = 0; a < 2; ++a)
#pragma unroll
            for (int b = 0; b < 2; ++b)
#pragma unroll
                for (int m = 0; m < 4; ++m)
#pragma unroll
                    for (int n = 0; n < 2; ++n) acc[a][b][m][n] = (f32x4){0.f, 0.f, 0.f, 0.f};
        cur = nxt; cA = nA; cB = nB; ++ui;
        if (wr == 1) PG8_BAR;
    }
    PG8_WAIT_V(0);
    PG8_BAR;
#undef PG8_SA
#undef PG8_SB
#undef PG8_STAGE
#undef PG8_LDA
#undef PG8_LDB
#undef PG8_MMA
#undef PG8_WAIT_V
#undef PG8_WAIT_L
#undef PG8_BAR
#undef PG8_SCHED
}

typedef f32x4 Acc[2][2][4][2];

struct EpiSwiGLU {
    bf16_t* O;
    DI void operator()(const Acc& acc, const Unit& u, int wr, int wc, int fr, int fq) const {
        const int row0 = u.pm * BM + wr * 64 + fr, col0 = u.pn * 128 + wc * 32 + 8 * fq;
#pragma unroll
        for (int ai = 0; ai < 2; ++ai)
#pragma unroll
            for (int m = 0; m < 4; ++m) {
                bf16_t* rowp = O + (size_t)(row0 + ai * HALF + m * 16) * FF + col0;
                const f32x4 g0 = acc[ai][0][m][0], g1 = acc[ai][0][m][1], u0 = acc[ai][1][m][0], u1 = acc[ai][1][m][1];
                u32x4 w;
                w.x = cvt_pk_bf16(silu_f(g0[0]) * u0[0], silu_f(g0[1]) * u0[1]); w.y = cvt_pk_bf16(silu_f(g0[2]) * u0[2], silu_f(g0[3]) * u0[3]);
                w.z = cvt_pk_bf16(silu_f(g1[0]) * u1[0], silu_f(g1[1]) * u1[1]); w.w = cvt_pk_bf16(silu_f(g1[2]) * u1[2], silu_f(g1[3]) * u1[3]);
                *(u32x4*)rowp = w;
            }
    }
};
template <int CS2, bool RS> struct EpiResid {
    const float* base; float* out; const float* gate; const float* rowss;
    DI void operator()(const Acc& acc, const Unit& u, int wr, int wc, int fr, int fq) const {
        const float* const base = this->base; float* const out = this->out; const float* const gate = this->gate; const float cscale = 0.5f * CS2; const float* const rowss = this->rowss;
        const int b = (u.pm * BM) >> 12;
        const int row0 = u.pm * BM + wr * 64 + fr, col0 = u.pn * BM + wc * 32 + 8 * fq;
        f32x4 gv[2][2];
#pragma unroll
        for (int bj = 0; bj < 2; ++bj)
#pragma unroll
            for (int n = 0; n < 2; ++n) gv[bj][n] = *(const f32x4*)(gate + (size_t)b * MODW + col0 + bj * HALF + 4 * n) * cscale;
#pragma unroll
        for (int ai = 0; ai < 2; ++ai)
#pragma unroll
            for (int m = 0; m < 4; ++m) {
                const int row = row0 + ai * HALF + m * 16;
                float rs = 1.f; if (RS) rs = rsqrtf(rowss[row] * (1.f / 1024.f) + EPS);
                const size_t off = (size_t)row * D + col0;
#pragma unroll
                for (int bj = 0; bj < 2; ++bj)
#pragma unroll
                    for (int n = 0; n < 2; ++n) { const f32x4 bs = *(const f32x4*)(base + off + bj * HALF + 4 * n);
                        *(f32x4*)(out + off + bj * HALF + 4 * n) = bs + gv[bj][n] * rs * acc[ai][bj][m][n]; }
                if (m & 1) asm volatile("" ::: "memory");
            }
    }
};
struct EpiProj {
    bf16_t* O;
    DI void operator()(const Acc& acc, const Unit& u, int wr, int wc, int fr, int fq) const {
        const int row0 = u.pm * BM + wr * 64 + fr, col0 = u.pn * BM + wc * 32 + 8 * fq;
        const bool act = u.pn < 8;
#pragma unroll
        for (int ai = 0; ai < 2; ++ai)
#pragma unroll
            for (int m = 0; m < 4; ++m) {
                bf16_t* rowp = O + (size_t)(row0 + ai * HALF + m * 16) * PW + col0;
#pragma unroll
                for (int bj = 0; bj < 2; ++bj) { f32x4 v0 = acc[ai][bj][m][0], v1 = acc[ai][bj][m][1];
                    if (act) {
#pragma unroll
                        for (int i = 0; i < 4; ++i) { v0[i] = gelu_tanh_f(v0[i]); v1[i] = gelu_tanh_f(v1[i]); } }
                    u32x4 w; w.x = cvt_pk_bf16(v0[0], v0[1]); w.y = cvt_pk_bf16(v0[2], v0[3]); w.z = cvt_pk_bf16(v1[0], v1[1]); w.w = cvt_pk_bf16(v1[2], v1[3]);
                    *(u32x4*)(rowp + bj * HALF) = w; }
            }
    }
};
struct EpiQK {
    bf16_t* Q; bf16_t* Kd; const float* qg; const float* kg; float qscale;
    DI void operator()(const Acc& acc, const Unit& u, int wr, int wc, int fr, int fq) const {
        const bool isq = u.pn < 4; const int hd = (4 * u.pn + wc) & 15;
        bf16_t* dst = isq ? Q : Kd; const float* gn = isq ? qg : kg; const float sc = isq ? qscale : 1.f;
        const int row0 = u.pm * BM + wr * 64 + fr;
#pragma unroll
        for (int ai = 0; ai < 2; ++ai)
#pragma unroll
            for (int m = 0; m < 4; ++m) {
                float ss = 0.f;
#pragma unroll
                for (int bj = 0; bj < 2; ++bj)
#pragma unroll
                    for (int n = 0; n < 2; ++n) { const f32x4 x = acc[ai][bj][m][n]; ss += (x[0] * x[0] + x[1] * x[1]) + (x[2] * x[2] + x[3] * x[3]); }
                ss += __shfl_xor(ss, 16); ss += __shfl_xor(ss, 32);
                const float rstd = rsqrtf(ss * (1.f / 64.f) + EPS);
                bf16_t* rowp = dst + (size_t)(row0 + ai * HALF + m * 16) * D + hd * 64 + 8 * fq;
#pragma unroll
                for (int bj = 0; bj < 2; ++bj) { const float rs2 = rstd * sc; const f32x4 v0 = acc[ai][bj][m][0] * rs2 * *(const f32x4*)(gn + 32 * bj + 8 * fq), v1 = acc[ai][bj][m][1] * rs2 * *(const f32x4*)(gn + 32 * bj + 8 * fq + 4);
                    u32x4 w; w.x = cvt_pk_bf16(v0[0], v0[1]); w.y = cvt_pk_bf16(v0[2], v0[3]); w.z = cvt_pk_bf16(v1[0], v1[1]); w.w = cvt_pk_bf16(v1[2], v1[3]);
                    *(u32x4*)(rowp + 32 * bj) = w; }
            }
    }
};
struct EpiPlain {
    bf16_t* O; int ldc;
    DI void operator()(const Acc& acc, const Unit& u, int wr, int wc, int fr, int fq) const {
        const int row0 = u.pm * BM + wr * 64 + fr, col0 = u.pn * BM + wc * 32 + 8 * fq;
#pragma unroll
        for (int ai = 0; ai < 2; ++ai)
#pragma unroll
            for (int m = 0; m < 4; ++m) {
                bf16_t* rowp = O + (size_t)(row0 + ai * HALF + m * 16) * ldc + col0;
#pragma unroll
                for (int bj = 0; bj < 2; ++bj) { const f32x4 v0 = acc[ai][bj][m][0], v1 = acc[ai][bj][m][1];
                    u32x4 w; w.x = cvt_pk_bf16(v0[0], v0[1]); w.y = cvt_pk_bf16(v0[2], v0[3]); w.z = cvt_pk_bf16(v1[0], v1[1]); w.w = cvt_pk_bf16(v1[2], v1[3]);
                    *(u32x4*)(rowp + bj * HALF) = w; }
            }
    }
};
}

struct TDesc { const float* src; int ld; int K; int N; bf16_t* dst; int ldt; int map; int rowadd; const float* kscale; };
DI void transpose_item(const TDesc& d, int k0, int n0, int drow, LAS float* scr, int lane) {
#pragma unroll 8
    for (int i = 0; i < 32; ++i) { const int kk = 2 * i + (lane >> 5); float v = d.src[(size_t)(k0 + kk) * d.ld + n0 + (lane & 31)]; if (d.kscale) v *= d.kscale[k0 + kk]; scr[kk * 33 + (lane & 31)] = v; }
    asm volatile("s_waitcnt lgkmcnt(0)" ::: "memory");
    const int c = lane & 7;
#pragma unroll
    for (int j = 0; j < 4; ++j) { const int n = (lane >> 3) + 8 * j; const LAS float* s = scr + (8 * c) * 33 + n;
        u32x4 o; o.x = pk2(s[0 * 33], s[1 * 33]); o.y = pk2(s[2 * 33], s[3 * 33]); o.z = pk2(s[4 * 33], s[5 * 33]); o.w = pk2(s[6 * 33], s[7 * 33]);
        *(u32x4*)(d.dst + (size_t)(drow + n) * d.ldt + k0 + 8 * c) = o; }
    asm volatile("s_waitcnt lgkmcnt(0)" ::: "memory");
}
DI void transpose_mat(const TDesc& d, int& base, int gw, int NGW, LAS float* scr, int lane) {
    const int nblk = d.N / 32, nitems = (d.K / 64) * nblk;
    int first = (gw - base) % NGW; if (first < 0) first += NGW;
    for (int it = first; it < nitems; it += NGW) {
        const int kb = it / nblk, nb = it % nblk, k0 = 64 * kb, n0 = 32 * nb;
        int drow;
        if (d.map == 0) drow = d.rowadd + n0;
        else if (d.map == 1) drow = 256 * (n0 >> 7) + (n0 & 127) + d.rowadd;
        else drow = 256 * (n0 >> 8) + 128 * ((n0 >> 5) & 1) + 32 * ((n0 >> 6) & 3);
        transpose_item(d, k0, n0, drow, scr, lane);
    }
    base = (base + nitems) % NGW;
}

struct Params { const float* in[23]; float* out; unsigned char* ws; };

DI void p0_phase(const Params& P, unsigned char* lds, int G) {
    int tid_ = threadIdx.x; asm volatile("" : "+v"(tid_));
    const int tid = tid_, lane = tid & 63, wave = tid >> 6;
    unsigned char* ws = P.ws;
    LAS float* scr = (LAS float*)((LAS unsigned char*)lds + wave * 9216);
    const int gw = blockIdx.x * NWAVES + wave, NGW = G * NWAVES;
    int base = 0;
    for (int f = 0; f < 4; ++f) {
        bf16_t* wgu = (bf16_t*)(ws + WS_WGU) + (size_t)f * 5632 * 1024;
        { TDesc d{P.in[5] + (size_t)f * D * FF, FF, D, FF, wgu, D, 1, 0, nullptr}; transpose_mat(d, base, gw, NGW, scr, lane); }
        { TDesc d{P.in[6] + (size_t)f * D * FF, FF, D, FF, wgu, D, 1, 128, nullptr}; transpose_mat(d, base, gw, NGW, scr, lane); }
        { TDesc d{P.in[7] + (size_t)f * FF * D, D, FF, D, (bf16_t*)(ws + WS_WDN) + (size_t)f * D * FF, FF, 0, 0, nullptr}; transpose_mat(d, base, gw, NGW, scr, lane); }
    }
    { TDesc d{P.in[8], INW, D, PW, (bf16_t*)(ws + WS_WIN), D, 0, 0, nullptr}; transpose_mat(d, base, gw, NGW, scr, lane); }
    { TDesc d{P.in[9], D, D, D, (bf16_t*)(ws + WS_WOUT1), D, 0, 0, nullptr}; transpose_mat(d, base, gw, NGW, scr, lane); }
    { TDesc d{P.in[9] + (size_t)D * D, D, D, D, (bf16_t*)(ws + WS_WOUT2), D, 0, 0, P.in[18]}; transpose_mat(d, base, gw, NGW, scr, lane); }
    { TDesc d{P.in[19], 3 * D, D, 2 * D, (bf16_t*)(ws + WS_WQK), D, 2, 0, nullptr}; transpose_mat(d, base, gw, NGW, scr, lane); }
    { TDesc d{P.in[19] + 2 * D, 3 * D, D, D, (bf16_t*)(ws + WS_WV), D, 0, 0, nullptr}; transpose_mat(d, base, gw, NGW, scr, lane); }
    { TDesc d{P.in[22], D, D, D, (bf16_t*)(ws + WS_WO), D, 0, 0, nullptr}; transpose_mat(d, base, gw, NGW, scr, lane); }
    float* rowss = (float*)(ws + WS_ROWSS);
    for (int i = blockIdx.x * NTHREADS + tid; i < T; i += G * NTHREADS) rowss[i] = 0.f;
    __syncthreads();
    float* sc = (float*)(lds + 81920);
    float* part = (float*)(lds + 114688);
    for (int i = tid; i < NB * D; i += NTHREADS) sc[i] = silu_f(P.in[1][i]);
    __syncthreads();
    float* mod = (float*)(ws + WS_MOD);
    for (int item = blockIdx.x; item < 288; item += G) {
        const int l = item / 144, n0 = (item % 144) * 64;
        const float* W = P.in[2] + (size_t)l * D * MODW + n0 + lane;
        float acc[8];
#pragma unroll
        for (int b = 0; b < 8; ++b) acc[b] = 0.f;
#pragma unroll 8
        for (int kk = 0; kk < 128; ++kk) { const int k = wave * 128 + kk; const float wv = W[(size_t)k * MODW];
#pragma unroll
            for (int b = 0; b < 8; ++b) acc[b] += sc[b * D + k] * wv; }
#pragma unroll
        for (int b = 0; b < 8; ++b) part[(wave * 8 + b) * 64 + lane] = acc[b];
        __syncthreads();
        { const int b = tid >> 6, col = tid & 63; float s = 0.f;
#pragma unroll
            for (int w = 0; w < 8; ++w) s += part[(w * 8 + b) * 64 + col];
            mod[(size_t)(l * 8 + b) * MODW + n0 + col] = s + P.in[3][(size_t)l * MODW + n0 + col]; }
        __syncthreads();
    }
}

template <bool PRE, bool MAIN, bool DT>
DI void norm_phase(const float* src, float* hdst, const float* gpre, bf16_t* xn, const float* g, const float* modl, float* dtraw, const float* w_in, unsigned char* lds, int G) {
    int tid_ = threadIdx.x; asm volatile("" : "+v"(tid_));
    const int tid = tid_, lane = tid & 63, wave = tid >> 6;
    const int gw = blockIdx.x * NWAVES + wave, NGW = G * NWAVES;
    float* wl = (float*)lds;
    if (DT) { for (int idx = tid; idx < 16384; idx += NTHREADS) { const int k = idx >> 4, hh = idx & 15; wl[hh * 1024 + k] = w_in[(size_t)k * INW + PW + hh]; } __syncthreads(); }
    for (int m = gw; m < T; m += NGW) {
        const f32x4* xr = (const f32x4*)(src + (size_t)m * D) + lane;
        f32x4 v[4]; float ss = 0.f;
#pragma unroll
        for (int j = 0; j < 4; ++j) { v[j] = xr[64 * j]; ss += (v[j][0] * v[j][0] + v[j][1] * v[j][1]) + (v[j][2] * v[j][2] + v[j][3] * v[j][3]); }
        if (PRE) {
            const float rstd = rsqrtf(wave_sum(ss) * (1.f / D) + EPS); ss = 0.f;
            f32x4* ho = (f32x4*)(hdst + (size_t)m * D) + lane;
#pragma unroll
            for (int j = 0; j < 4; ++j) { const f32x4 gp = ((const f32x4*)gpre)[lane + 64 * j]; v[j] = v[j] * rstd * gp; ho[64 * j] = v[j];
                ss += (v[j][0] * v[j][0] + v[j][1] * v[j][1]) + (v[j][2] * v[j][2] + v[j][3] * v[j][3]); }
        }
        if (MAIN) {
            const float rstd = rsqrtf(wave_sum(ss) * (1.f / D) + EPS);
            const int b = m >> 12;
            const f32x4* sh = (const f32x4*)(modl + (size_t)b * MODW) + lane; const f32x4* scl = (const f32x4*)(modl + (size_t)b * MODW + D) + lane;
            u32x2* o8 = (u32x2*)(xn + (size_t)m * D) + lane;
#pragma unroll
            for (int j = 0; j < 4; ++j) { const f32x4 gg = ((const f32x4*)g)[lane + 64 * j]; const f32x4 y = v[j] * rstd * gg * (scl[64 * j] + 1.f) + sh[64 * j]; v[j] = y;
                u32x2 w; w.x = pk2(y[0], y[1]); w.y = pk2(y[2], y[3]); o8[64 * j] = w; }
            if (DT) {
                float d[16];
#pragma unroll
                for (int hh = 0; hh < 16; ++hh) { float a = 0.f;
#pragma unroll
                    for (int j = 0; j < 4; ++j) { const f32x4 w4 = *(const f32x4*)(wl + hh * 1024 + 4 * (lane + 64 * j)); a += (v[j][0] * w4[0] + v[j][1] * w4[1]) + (v[j][2] * w4[2] + v[j][3] * w4[3]); }
                    d[hh] = a; if ((hh & 3) == 3) asm volatile("" ::: "memory"); }
                { const bool hb = (lane & 32) != 0;
#pragma unroll
                    for (int i = 0; i < 8; ++i) { const float keep = hb ? d[i + 8] : d[i], send = hb ? d[i] : d[i + 8]; d[i] = keep + __shfl_xor(send, 32); } }
                { const bool hb = (lane & 16) != 0;
#pragma unroll
                    for (int i = 0; i < 4; ++i) { const float keep = hb ? d[i + 4] : d[i], send = hb ? d[i] : d[i + 4]; d[i] = keep + __shfl_xor(send, 16); } }
                { const bool hb = (lane & 8) != 0;
#pragma unroll
                    for (int i = 0; i < 2; ++i) { const float keep = hb ? d[i + 2] : d[i], send = hb ? d[i] : d[i + 2]; d[i] = keep + __shfl_xor(send, 8); } }
                { const bool hb = (lane & 4) != 0; const float keep = hb ? d[1] : d[0], send = hb ? d[0] : d[1]; d[0] = keep + __shfl_xor(send, 4); }
                d[0] += __shfl_xor(d[0], 1); d[0] += __shfl_xor(d[0], 2);
                const int hh = ((lane >> 5) & 1) * 8 + ((lane >> 4) & 1) * 4 + ((lane >> 3) & 1) * 2 + ((lane >> 2) & 1);
                if ((lane & 3) == 0) dtraw[(size_t)m * 16 + hh] = d[0];
            }
        }
    }
}

DI void gmlp_item(int item, bf16_t* PROJ, const float* vg, const float* wsp, const float* bsp, unsigned char* lds) {
    int tid_ = threadIdx.x; asm volatile("" : "+v"(tid_));
    const int tid = tid_, lane = tid & 63, wave = tid >> 6, fr = lane & 15, fq = lane >> 4;
    const int b = item >> 8, blk = (item >> 3) & 31, g = item & 7;
    const int r0 = b * SEQ + blk * 128;
    bf16_t* vnT = (bf16_t*)lds;
    bf16_t* Wm = vnT + 128 * 136;
    {
        const int row = tid >> 2, q4 = tid & 3;
        const bf16_t* vp = PROJ + (size_t)(r0 + row) * PW + 1024 + g * 128 + q4 * 32;
        u32x4 raw[4];
#pragma unroll
        for (int i = 0; i < 4; ++i) raw[i] = *(const u32x4*)(vp + 8 * i);
        float f[32]; float ss = 0.f;
#pragma unroll
        for (int i = 0; i < 4; ++i)
#pragma unroll
            for (int e = 0; e < 4; ++e) { const unsigned u = raw[i][e]; f[8 * i + 2 * e] = bflo(u); f[8 * i + 2 * e + 1] = bfhi(u); }
#pragma unroll
        for (int i = 0; i < 32; ++i) ss += f[i] * f[i];
        ss += __shfl_xor(ss, 1); ss += __shfl_xor(ss, 2);
        const float rstd = rsqrtf(ss * (1.f / 128.f) + EPS);
        const float* gp = vg + g * 128 + q4 * 32;
#pragma unroll
        for (int i = 0; i < 32; ++i) vnT[(q4 * 32 + i) * 136 + row] = (bf16_t)f2bf(f[i] * rstd * gp[i]);
        const float* wp = wsp + ((size_t)g * 128 + row) * 128 + q4 * 32;
#pragma unroll
        for (int i = 0; i < 8; ++i) { f32x4 w4 = *(const f32x4*)(wp + 4 * i);
            if (row < 64 && q4 >= 2) w4 = (f32x4){0.f, 0.f, 0.f, 0.f};
            u32x2 o; o.x = pk2(w4[0], w4[1]); o.y = pk2(w4[2], w4[3]); *(u32x2*)(Wm + row * 136 + q4 * 32 + 4 * i) = o; }
    }
    __syncthreads();
    f32x4 acc[8];
#pragma unroll
    for (int ct = 0; ct < 8; ++ct) acc[ct] = (f32x4){0.f, 0.f, 0.f, 0.f};
    const int nks = (wave < 4) ? 2 : 4;
    for (int ks = 0; ks < nks; ++ks) {
        const bf16x8 af = *(const bf16x8*)(Wm + (16 * wave + fr) * 136 + 32 * ks + 8 * fq);
#pragma unroll
        for (int ct = 0; ct < 8; ++ct) { const bf16x8 bfr = *(const bf16x8*)(vnT + (16 * ct + fr) * 136 + 32 * ks + 8 * fq);
            acc[ct] = __builtin_amdgcn_mfma_f32_16x16x32_bf16(bfr, af, acc[ct], 0, 0, 0); }
    }
    {
        const int t = 16 * wave + fr; const float bias = bsp[g * 128 + t];
        bf16_t* up = PROJ + (size_t)(r0 + t) * PW + g * 128 + 4 * fq;
#pragma unroll
        for (int ct = 0; ct < 8; ++ct) { const u32x2 u2 = *(const u32x2*)(up + 16 * ct);
            u32x2 o; o.x = pk2(bflo(u2.x) * (acc[ct][0] + bias), bfhi(u2.x) * (acc[ct][1] + bias)); o.y = pk2(bflo(u2.y) * (acc[ct][2] + bias), bfhi(u2.y) * (acc[ct][3] + bias));
            *(u32x2*)(up + 16 * ct) = o; }
    }
    __syncthreads();
}

DI void ssd_item(int item, bf16_t* PROJ, bf16_t* ybase, int ldy, const float* dtraw, const float* conv_w, const float* conv_b, const float* dt_bias, const float* a_log, const float* dskip, float* rowss, unsigned char* lds) {
    int tid_ = threadIdx.x; asm volatile("" : "+v"(tid_));
    const int tid = tid_, lane = tid & 63, wave = tid >> 6, fr = lane & 15, fq = lane >> 4, r32 = lane & 31, hi = lane >> 5;
    const int b = item >> 4, hd = item & 15, g = hd >> 3;
    float* dtv = (float*)lds; float* csv = dtv + 4096;
    bf16_t* Cn = (bf16_t*)(lds + 32768);
    bf16_t* Bn = Cn + 64 * 136;
    bf16_t* BsT = Bn + 64 * 136;
    bf16_t* xsT = BsT + 128 * 72;
    bf16_t* Wl = xsT + 64 * 72;
    bf16_t* Hb = Wl + 64 * 72;
    const float Aneg = -__expf(a_log[hd]), dtb = dt_bias[hd], Dk = dskip[hd];
    for (int i = 0; i < 8; ++i) {
        const int t = (wave + 8 * i) * 64 + lane;
        const float raw = dtraw[(size_t)(b * SEQ + t) * 16 + hd] + dtb;
        const float dt = raw > 20.f ? raw : softplus_f(raw);
        float x = dt * Aneg;
#pragma unroll
        for (int o = 1; o < 64; o <<= 1) { const float y = __shfl_up(x, o); if (lane >= o) x += y; }
        dtv[t] = dt; csv[t] = x;
    }
    for (int idx = tid; idx < 64 * 136 / 2; idx += NTHREADS) ((unsigned*)Hb)[idx] = 0u;
    const bool active = tid < 320; const int cgp = tid % 40, rb = (tid / 40) & 7;
    const int col = cgp < 8 ? 3072 + hd * 64 + 8 * cgp : (cgp < 24 ? 4096 + g * 128 + 8 * (cgp - 8) : 4352 + g * 128 + 8 * (cgp - 24));
    const int ch0 = col - 3072;
    float* cwl = (float*)(lds + 121856);
    if (active) {
#pragma unroll
        for (int k = 0; k < 4; ++k)
#pragma unroll
            for (int i = 0; i < 8; ++i) cwl[k * 320 + cgp * 8 + i] = conv_w[k * 1536 + ch0 + i];
#pragma unroll
        for (int i = 0; i < 8; ++i) cwl[4 * 320 + cgp * 8 + i] = conv_b[ch0 + i];
    }
    f32x16 Hacc;
#pragma unroll
    for (int r = 0; r < 16; ++r) Hacc[r] = 0.f;
    u32x4 raw[11];
    const bf16_t* xcol = PROJ + (size_t)(b * SEQ) * PW + col;
#define SSD_LOAD_RAW(c) do { _Pragma("unroll") for (int i = 0; i < 11; ++i) { const int t = (c) * 64 + rb * 8 + i - 3; \
        raw[i] = (t >= 0) ? *(const u32x4*)(xcol + (size_t)t * PW) : (u32x4){0u, 0u, 0u, 0u}; } } while (0)
    if (active) SSD_LOAD_RAW(0);
    __syncthreads();
    const int tt = wave >> 1, half = wave & 1;
    for (int c = 0; c < 64; ++c) {
        const int tb = c * 64;
        if (active) {
            float o[8][8];
#pragma unroll
            for (int e = 0; e < 4; ++e) {
                const float* cwp = cwl + cgp * 8 + 2 * e;
                const float w00 = cwp[0], w01 = cwp[1], w10 = cwp[320], w11 = cwp[321], w20 = cwp[640], w21 = cwp[641], w30 = cwp[960], w31 = cwp[961], b0 = cwp[1280], b1 = cwp[1281];
#pragma unroll
                for (int i = 0; i < 8; ++i) {
                    const unsigned u0 = raw[i][e], u1 = raw[i + 1][e], u2 = raw[i + 2][e], u3 = raw[i + 3][e];
                    const float a0 = b0 + w00 * bflo(u0) + w10 * bflo(u1) + w20 * bflo(u2) + w30 * bflo(u3);
                    const float a1 = b1 + w01 * bfhi(u0) + w11 * bfhi(u1) + w21 * bfhi(u2) + w31 * bfhi(u3);
                    o[i][2 * e] = silu_f(a0); o[i][2 * e + 1] = silu_f(a1);
                }
            }
            if (cgp < 8) {
#pragma unroll
                for (int cc = 0; cc < 8; ++cc) { u32x4 w; w.x = pk2(o[0][cc], o[1][cc]); w.y = pk2(o[2][cc], o[3][cc]); w.z = pk2(o[4][cc], o[5][cc]); w.w = pk2(o[6][cc], o[7][cc]);
                    *(u32x4*)(xsT + (8 * cgp + cc) * 72 + rb * 8) = w; }
            } else if (cgp < 24) {
                const int n0 = 8 * (cgp - 8);
                const float cse = csv[tb + 63];
                float dte[8];
#pragma unroll
                for (int i = 0; i < 8; ++i) { const int t = tb + rb * 8 + i; dte[i] = __expf(cse - csv[t]) * dtv[t]; }
#pragma unroll
                for (int i = 0; i < 8; ++i) { u32x4 w; w.x = pk2(o[i][0], o[i][1]); w.y = pk2(o[i][2], o[i][3]); w.z = pk2(o[i][4], o[i][5]); w.w = pk2(o[i][6], o[i][7]);
                    *(u32x4*)(Bn + (rb * 8 + i) * 136 + n0) = w; }
#pragma unroll
                for (int cc = 0; cc < 8; ++cc) { u32x4 w; w.x = pk2(o[0][cc] * dte[0], o[1][cc] * dte[1]); w.y = pk2(o[2][cc] * dte[2], o[3][cc] * dte[3]);
                    w.z = pk2(o[4][cc] * dte[4], o[5][cc] * dte[5]); w.w = pk2(o[6][cc] * dte[6], o[7][cc] * dte[7]);
                    *(u32x4*)(BsT + (n0 + cc) * 72 + rb * 8) = w; }
            } else {
                const int n0 = 8 * (cgp - 24);
#pragma unroll
                for (int i = 0; i < 8; ++i) { u32x4 w; w.x = pk2(o[i][0], o[i][1]); w.y = pk2(o[i][2], o[i][3]); w.z = pk2(o[i][4], o[i][5]); w.w = pk2(o[i][6], o[i][7]);
                    *(u32x4*)(Cn + (rb * 8 + i) * 136 + n0) = w; }
            }
            if (c < 63) SSD_LOAD_RAW(c + 1);
        }
        __syncthreads();
        const int trow = 16 * tt + fr;
        bf16_t* zrow = PROJ + (size_t)(b * SEQ + tb + trow) * PW + 2048 + hd * 64 + 4 * fq;
        u32x2 zr[2];
#pragma unroll
        for (int p2 = 0; p2 < 2; ++p2) zr[p2] = *(const u32x2*)(zrow + 16 * (2 * half + p2));
        const float cs_t = csv[tb + trow];
        bf16x8 cf[4];
#pragma unroll
        for (int ks = 0; ks < 4; ++ks) cf[ks] = *(const bf16x8*)(Cn + trow * 136 + 32 * ks + 8 * fq);
#pragma unroll
        for (int s2 = 0; s2 < 2; ++s2) {
            const int st = 2 * half + s2;
            u32x2 w; w.x = 0u; w.y = 0u;
            if (st <= tt) {
                f32x4 ga = (f32x4){0.f, 0.f, 0.f, 0.f};
#pragma unroll
                for (int ks = 0; ks < 4; ++ks) { const bf16x8 bfr = *(const bf16x8*)(Bn + (16 * st + fr) * 136 + 32 * ks + 8 * fq);
                    ga = __builtin_amdgcn_mfma_f32_16x16x32_bf16(bfr, cf[ks], ga, 0, 0, 0); }
                float wv[4];
#pragma unroll
                for (int j = 0; j < 4; ++j) { const int s = 16 * st + 4 * fq + j;
                    float val = (s <= trow) ? ga[j] * __expf(cs_t - csv[tb + s]) * dtv[tb + s] : 0.f;
                    if (s == trow) val += Dk;
                    wv[j] = val; }
                w.x = pk2(wv[0], wv[1]); w.y = pk2(wv[2], wv[3]);
            }
            *(u32x2*)(Wl + trow * 72 + 16 * st + 4 * fq) = w;
        }
        f32x4 ya[2];
#pragma unroll
        for (int p2 = 0; p2 < 2; ++p2) { ya[p2] = (f32x4){0.f, 0.f, 0.f, 0.f}; const int pt = 2 * half + p2;
#pragma unroll
            for (int ks = 0; ks < 4; ++ks) { const bf16x8 hf = *(const bf16x8*)(Hb + (16 * pt + fr) * 136 + 32 * ks + 8 * fq);
                ya[p2] = __builtin_amdgcn_mfma_f32_16x16x32_bf16(hf, cf[ks], ya[p2], 0, 0, 0); }
            ya[p2] = ya[p2] * __expf(cs_t); }
        __syncthreads();
        {
            const int nks = (tt < 2) ? 1 : 2;
            for (int ks = 0; ks < nks; ++ks) { const bf16x8 wf = *(const bf16x8*)(Wl + trow * 72 + 32 * ks + 8 * fq);
#pragma unroll
                for (int p2 = 0; p2 < 2; ++p2) { const bf16x8 xf = *(const bf16x8*)(xsT + (16 * (2 * half + p2) + fr) * 72 + 32 * ks + 8 * fq);
                    ya[p2] = __builtin_amdgcn_mfma_f32_16x16x32_bf16(xf, wf, ya[p2], 0, 0, 0); } }
            float ss = 0.f;
#pragma unroll
            for (int p2 = 0; p2 < 2; ++p2) { const float z0 = bflo(zr[p2].x), z1 = bfhi(zr[p2].x), z2 = bflo(zr[p2].y), z3 = bfhi(zr[p2].y);
                const float y0 = ya[p2][0] * silu_f(z0), y1 = ya[p2][1] * silu_f(z1), y2 = ya[p2][2] * silu_f(z2), y3 = ya[p2][3] * silu_f(z3);
                ss += (y0 * y0 + y1 * y1) + (y2 * y2 + y3 * y3);
                u32x2 o; o.x = pk2(y0, y1); o.y = pk2(y2, y3); *(u32x2*)(ybase + (size_t)(b * SEQ + tb + trow) * ldy + hd * 64 + 4 * fq + 16 * (2 * half + p2)) = o; }
            ss += __shfl_xor(ss, 16); ss += __shfl_xor(ss, 32);
            if (fq == 0) atomicAdd(rowss + (size_t)(b * SEQ + tb + trow), ss);
            const int pp = wave >> 2, nn = wave & 3;
            const float cd = __expf(csv[tb + 63]);
#pragma unroll
            for (int r = 0; r < 16; ++r) Hacc[r] *= cd;
#pragma unroll
            for (int ks = 0; ks < 4; ++ks) { const bf16x8 bf = *(const bf16x8*)(BsT + (32 * nn + r32) * 72 + 16 * ks + 8 * hi);
                const bf16x8 xf = *(const bf16x8*)(xsT + (32 * pp + r32) * 72 + 16 * ks + 8 * hi);
                Hacc = __builtin_amdgcn_mfma_f32_32x32x16_bf16(bf, xf, Hacc, 0, 0, 0); }
#pragma unroll
            for (int r4 = 0; r4 < 4; ++r4) { u32x2 o; o.x = pk2(Hacc[4 * r4], Hacc[4 * r4 + 1]); o.y = pk2(Hacc[4 * r4 + 2], Hacc[4 * r4 + 3]);
                *(u32x2*)(Hb + (32 * pp + r32) * 136 + 32 * nn + 8 * r4 + 4 * hi) = o; }
        }
        __syncthreads();
    }
#undef SSD_LOAD_RAW
}

DI int pi32(int m) { return (m & ~12) | ((m & 4) << 1) | ((m & 8) >> 1); }
DI void attn_phase(const bf16_t* Q, const bf16_t* Kg, const bf16_t* Vt, bf16_t* O, unsigned char* lds, int G) {
    int tid_ = threadIdx.x; asm volatile("" : "+v"(tid_));
    const int tid = tid_, lane = tid & 63, wave = tid >> 6, r32 = lane & 31, hi = lane >> 5;
    const int key = tid >> 3, ch = tid & 7, stoff = key * 144 + ch * 16;
    const int krow = pi32(r32);
    unsigned* aflag = (unsigned*)(lds + 36864);
    for (int v = blockIdx.x; v < 256; v += G) {
        const int bh = v >> 1, par = v & 1, b = bh >> 4, hd = bh & 15;
        const bf16_t* kgp = Kg + (size_t)(b * SEQ + key) * D + hd * 64 + 8 * ch;
        const bf16_t* vgp = Vt + (size_t)(hd * 64 + key) * T + b * SEQ + 8 * ch;
        for (int ui = 0; ui < 8; ++ui) {
            const int s_ = par * 4 + (ui >> 1), qb = (ui & 1) ? 15 - s_ : s_;
            const int q0 = qb * 256, qw = q0 + 32 * wave, NT = 4 * qb + 4, tq = qw >> 6;
            const bf16_t* qp = Q + (size_t)(b * SEQ + qw + r32) * D + hd * 64 + 8 * hi;
            bf16x8 qf[4];
#pragma unroll
            for (int d0 = 0; d0 < 4; ++d0) qf[d0] = *(const bf16x8*)(qp + 16 * d0);
            f32x16 o0, o1;
#pragma unroll
            for (int r = 0; r < 16; ++r) { o0[r] = 0.f; o1[r] = 0.f; }
            float run = 0.f;
            u32x4 kr = *(const u32x4*)(kgp + (size_t)(NT - 1) * 64 * D), vr = *(const u32x4*)(vgp + (NT - 1) * 64);
            *(u32x4*)(lds + stoff) = kr; *(u32x4*)(lds + 9216 + stoff) = vr;
            __syncthreads();
            int buf = 0;
            for (int i = NT - 1; i >= 0; --i, buf ^= 1) {
                if (i > 0) { kr = *(const u32x4*)(kgp + (size_t)(i - 1) * 64 * D); vr = *(const u32x4*)(vgp + (i - 1) * 64); }
                if (i <= tq) {
                    const unsigned char* Kl = lds + buf * 18432; const unsigned char* Vl = Kl + 9216;
                    f32x16 p[2];
#pragma unroll
                    for (int kb = 0; kb < 2; ++kb) {
#pragma unroll
                        for (int r = 0; r < 16; ++r) p[kb][r] = 0.f;
#pragma unroll
                        for (int d0 = 0; d0 < 4; ++d0) { const bf16x8 kf = *(const bf16x8*)(Kl + (32 * kb + krow) * 144 + (16 * d0 + 8 * hi) * 2);
                            p[kb] = __builtin_amdgcn_mfma_f32_32x32x16_bf16(kf, qf[d0], p[kb], 0, 0, 0); }
                    }
                    const bool masked = (i == tq);
                    float lk[2][16];
#pragma unroll
                    for (int kb = 0; kb < 2; ++kb)
#pragma unroll
                        for (int r = 0; r < 16; ++r) {
                            const float z = p[kb][r];
                            const float sp = fmaxf(z, 0.f) + lg2(1.f + ex2(-fabsf(z)));
                            float lkv = -sp, lb = z - sp;
                            if (masked) { const int ka = 64 * i + 32 * kb + 16 * (r >> 3) + 8 * hi + (r & 7); const bool valid = ka < qw + r32; lkv = valid ? lkv : 0.f; lb = valid ? lb : -INFINITY; }
                            lk[kb][r] = lkv; p[kb][r] = lb;
                        }
                    float glo[2][2], ghi[2][2];
#pragma unroll
                    for (int kb = 0; kb < 2; ++kb)
#pragma unroll
                        for (int s = 0; s < 2; ++s) { float gs = 0.f;
#pragma unroll
                            for (int j = 0; j < 8; ++j) gs += lk[kb][8 * s + j];
                            auto rr = __builtin_amdgcn_permlane32_swap(__float_as_uint(gs), __float_as_uint(gs), false, false);
                            glo[kb][s] = __uint_as_float(rr[0]); ghi[kb][s] = __uint_as_float(rr[1]); }
                    float basev = run;
#pragma unroll
                    for (int kb = 1; kb >= 0; --kb)
#pragma unroll
                        for (int s = 1; s >= 0; --s) {
                            float a = basev + (hi == 0 ? ghi[kb][s] : 0.f);
#pragma unroll
                            for (int j = 7; j >= 0; --j) { const float w = ex2(p[kb][8 * s + j] + a); a += lk[kb][8 * s + j]; p[kb][8 * s + j] = w; }
                            basev += glo[kb][s] + ghi[kb][s];
                        }
                    run = basev;
#pragma unroll
                    for (int kb = 0; kb < 2; ++kb)
#pragma unroll
                        for (int s = 0; s < 2; ++s) {
                            u32x4 pw; pw.x = cvt_pk_bf16(p[kb][8 * s + 0], p[kb][8 * s + 1]); pw.y = cvt_pk_bf16(p[kb][8 * s + 2], p[kb][8 * s + 3]);
                            pw.z = cvt_pk_bf16(p[kb][8 * s + 4], p[kb][8 * s + 5]); pw.w = cvt_pk_bf16(p[kb][8 * s + 6], p[kb][8 * s + 7]);
                            const bf16x8 pa = __builtin_bit_cast(bf16x8, pw);
                            const bf16x8 v0 = *(const bf16x8*)(Vl + (r32) * 144 + (32 * kb + 16 * s + 8 * hi) * 2);
                            const bf16x8 v1 = *(const bf16x8*)(Vl + (32 + r32) * 144 + (32 * kb + 16 * s + 8 * hi) * 2);
                            o0 = __builtin_amdgcn_mfma_f32_32x32x16_bf16(pa, v0, o0, 0, 0, 0);
                            o1 = __builtin_amdgcn_mfma_f32_32x32x16_bf16(pa, v1, o1, 0, 0, 0);
                        }
                }
                if (i > 0) { *(u32x4*)(lds + (buf ^ 1) * 18432 + stoff) = kr; *(u32x4*)(lds + (buf ^ 1) * 18432 + 9216 + stoff) = vr; }
                if (lane == 0) aflag[buf * 8 + wave] = __any(run > -100.f) ? 1u : 0u;
                __syncthreads();
                { const u32x4 f0 = *(const u32x4*)(aflag + buf * 8), f1 = *(const u32x4*)(aflag + buf * 8 + 4);
                  if (((f0.x | f0.y) | (f0.z | f0.w) | (f1.x | f1.y) | (f1.z | f1.w)) == 0u) break; }
            }
            bf16_t* op = O + (size_t)(b * SEQ + qw) * D + hd * 64 + r32;
#pragma unroll
            for (int r = 0; r < 16; ++r) { const int qrow = (r & 3) + 8 * (r >> 2) + 4 * hi;
                op[(size_t)qrow * D] = (bf16_t)f2bf(o0[r]); op[(size_t)qrow * D + 32] = (bf16_t)f2bf(o1[r]); }
        }
    }
}


#define XB_TMO      128
#define XB_XCNT(j)  (256  + 64 * (j))
#define XB_XSUB(j)  (1280 + 64 * (j))
#define XB_XGEN(j)  (2304 + 64 * (j))
#define XB_TOP      3328
#define XB_TOPGEN   3392
#define XCD_BAR_WORDS 3456
#define XB_SPIN_CAP (1u << 18)
DI unsigned xb_ld(unsigned* p)              { return __hip_atomic_load(p, __ATOMIC_RELAXED, __HIP_MEMORY_SCOPE_AGENT); }
DI unsigned xb_add(unsigned* p, unsigned v) { return __hip_atomic_fetch_add(p, v, __ATOMIC_RELAXED, __HIP_MEMORY_SCOPE_AGENT); }
DI unsigned xb_xcc_id() { return (unsigned)__builtin_amdgcn_s_getreg((3 << 11) | 20) & 0xFu; }
#define XB_SPIN(cond, bar) do { unsigned _sp = 0; while (cond) { __builtin_amdgcn_s_sleep(1); \
    if ((++_sp & 255u) == 0u) { if (xb_ld(&(bar)[XB_TMO])) break; if (_sp > XB_SPIN_CAP) { atomicAdd(&(bar)[XB_TMO], 1u); break; } } } } while (0)
struct XcdBarrier { unsigned* bar; unsigned x; volatile LAS unsigned* st; };
DI XcdBarrier xcd_barrier_post(unsigned* bar, volatile LAS unsigned* st) {
    XcdBarrier b; b.bar = bar; b.x = xb_xcc_id(); b.st = st;
    if (threadIdx.x == 0) (void)xb_add(&bar[XB_XCNT(b.x)], 1u);
    return b;
}
DI void xcd_barrier_complete(unsigned* bar, unsigned x, unsigned& nloc, unsigned& nx) {
    const unsigned G = gridDim.x * gridDim.y * gridDim.z;
    unsigned sum, cnt, mine, sp = 0u;
    for (;;) {
        sum = 0u; cnt = 0u; mine = 0u;
#pragma unroll
        for (unsigned j = 0; j < 16; ++j) { const unsigned c = xb_ld(&bar[XB_XCNT(j)]); sum += c; cnt += (c > 0u) ? 1u : 0u; mine = (j == x) ? c : mine; }
        if (sum == G) break;
        __builtin_amdgcn_s_sleep(1);
        if ((++sp & 255u) == 0u) { if (xb_ld(&bar[XB_TMO])) break; if (sp > XB_SPIN_CAP) { atomicAdd(&bar[XB_TMO], 1u); break; } }
    }
    nloc = mine > 0u ? mine : 1u; nx = cnt > 0u ? cnt : 1u;
}
DI void xcd_barrier(const XcdBarrier& b) {
    asm volatile("s_waitcnt vmcnt(0)" ::: "memory");
    __syncthreads();
    if (threadIdx.x == 0) {
        unsigned* bar = b.bar;
        __builtin_amdgcn_s_waitcnt(0);
        unsigned nloc = b.st[0], nx = b.st[1];
        if (nloc == 0u) { xcd_barrier_complete(bar, b.x, nloc, nx); b.st[0] = nloc; b.st[1] = nx; }
        const unsigned old = xb_add(&bar[XB_XSUB(b.x)], 1u);
        const unsigned gen = old / nloc;
        if (old + 1u == (gen + 1u) * nloc) {
            __builtin_amdgcn_fence(__ATOMIC_RELEASE, "agent");
            asm volatile("s_waitcnt vmcnt(0)" ::: "memory");
            const unsigned og = xb_add(&bar[XB_TOP], 1u);
            const unsigned tg = og / nx;
            if (og + 1u == (tg + 1u) * nx) xb_add(&bar[XB_TOPGEN], 1u);
            else XB_SPIN(xb_ld(&bar[XB_TOPGEN]) == tg, bar);
            __builtin_amdgcn_fence(__ATOMIC_ACQUIRE, "agent");
            xb_add(&bar[XB_XGEN(b.x)], 1u);
            asm volatile("s_waitcnt vmcnt(0)" ::: "memory");
        } else {
            XB_SPIN(xb_ld(&bar[XB_XGEN(b.x)]) == gen, bar);
            __builtin_amdgcn_fence(__ATOMIC_ACQUIRE, "agent");
            asm volatile("s_waitcnt vmcnt(0)" ::: "memory");
        }
    }
    __syncthreads();
}
#ifndef PM
#define PM 0xFFFF
#endif
#define PH(bit) if constexpr ((PM >> (bit)) & 1)
#ifdef USE_CG_SYNC
#define GSYNC() grid.sync()
#else
#define GSYNC() xcd_barrier(xbar)
#endif
__global__ void __launch_bounds__(NTHREADS, 2) fwd_megakernel(Params P) {
    extern __shared__ __attribute__((aligned(16))) unsigned char lds[];
    cg::grid_group grid = cg::this_grid();
    const int G = gridDim.x, bid = blockIdx.x;
    unsigned char* ws = P.ws;
    LAS unsigned char* ldsl = (LAS unsigned char*)lds;
    float* mod = (float*)(ws + WS_MOD);
    float* rowss = (float*)(ws + WS_ROWSS);
    float* dtraw = (float*)(ws + WS_DT);
    bf16_t* XN = (bf16_t*)(ws + WS_XN);
    bf16_t* BIG = (bf16_t*)(ws + WS_BIG);
    float* H = P.out;
    const float* normg = P.in[4];

    unsigned* barw = (unsigned*)(ws + WS_ROWSS + 512 * 1024);
    if (bid == 0) for (int i = threadIdx.x; i < XCD_BAR_WORDS; i += NTHREADS) barw[i] = 0u;
    volatile LAS unsigned* xst = (volatile LAS unsigned*)(ldsl + 147456 - 64);
    if (threadIdx.x < 2) xst[threadIdx.x] = 0u;
    PH(0) p0_phase(P, lds, G);
#ifdef REP_P0
    __syncthreads(); p0_phase(P, lds, G);
#endif
    grid.sync();
    XcdBarrier xbar = xcd_barrier_post(barw, xst);

    for (int l = 0; l < 2; ++l) {
        const float* modl = mod + (size_t)l * 8 * MODW;
        PH(1) { if (l == 0) { norm_phase<false, true, false>(P.in[0], nullptr, nullptr, XN, normg + (l * 4 + 0) * D, modl + 0 * 3072, nullptr, nullptr, lds, G);
#ifdef REP_N1
            __syncthreads(); norm_phase<false, true, false>(P.in[0], nullptr, nullptr, XN, normg + (l * 4 + 0) * D, modl + 0 * 3072, nullptr, nullptr, lds, G);
#endif
        }
        else        norm_phase<true, true, false>(H, H, normg + (0 * 4 + 3) * D, XN, normg + (l * 4 + 0) * D, modl + 0 * 3072, nullptr, nullptr, lds, G); }
        GSYNC();
        for (int i = 0; i < 2; ++i) {
            const int f = l * 2 + i;
            if (i == 1) { PH(1) norm_phase<false, true, false>(H, nullptr, nullptr, XN, normg + (l * 4 + 2) * D, modl + 2 * 3072, nullptr, nullptr, lds, G); GSYNC(); }
            PH(2) { pg8::Gemm g{XN, (const bf16_t*)(ws + WS_WGU) + (size_t)f * 5632 * 1024, T, 5632, D, D}; pg8::StaticOrder S; S.init(T, 5632, G, bid);
              pg8::EpiSwiGLU E{BIG}; pg8::gemm_phase(ldsl, g, S, E); }
#ifdef REP_GU
            if (f == 0) { __syncthreads(); pg8::Gemm g{XN, (const bf16_t*)(ws + WS_WGU) + (size_t)f * 5632 * 1024, T, 5632, D, D}; pg8::StaticOrder S; S.init(T, 5632, G, bid);
              pg8::EpiSwiGLU E{BIG}; pg8::gemm_phase(ldsl, g, S, E); }
#endif
            GSYNC();
            PH(3) { pg8::Gemm g{BIG, (const bf16_t*)(ws + WS_WDN) + (size_t)f * D * FF, T, D, FF, FF}; pg8::StaticOrder S; S.init(T, D, G, bid);
              pg8::EpiResid<1, false> E{(l == 0 && i == 0) ? P.in[0] : H, H, modl + (i == 0 ? 0 : 2) * 3072 + 2048, rowss}; pg8::gemm_phase(ldsl, g, S, E); }
            GSYNC();
            if (i == 0) {
                if (l == 0) {
                    PH(1) norm_phase<false, true, true>(H, nullptr, nullptr, XN, normg + (l * 4 + 1) * D, modl + 1 * 3072, dtraw, P.in[8], lds, G);
                    GSYNC();
                    PH(4) { pg8::Gemm g{XN, (const bf16_t*)(ws + WS_WIN), T, PW, D, D}; pg8::StaticOrder S; S.init(T, PW, G, bid);
                      pg8::EpiProj E{BIG}; pg8::gemm_phase(ldsl, g, S, E); }
                    GSYNC();
                    if (G >= 256) {
#ifdef REP_SSD
                        if (bid < 128) { ssd_item(bid, BIG, XN, D, dtraw, P.in[13], P.in[14], P.in[15], P.in[16], P.in[17], rowss + 65536, lds); __syncthreads(); }
#endif
                        if (bid < 128) { PH(5) ssd_item(bid, BIG, BIG + 2048, PW, dtraw, P.in[13], P.in[14], P.in[15], P.in[16], P.in[17], rowss, lds); }
                        else { PH(6) for (int it = bid - 128; it < 2048; it += G - 128) gmlp_item(it, BIG, P.in[10], P.in[11], P.in[12], lds); }
                    } else {
                        PH(5) for (int it = bid; it < 128; it += G) { ssd_item(it, BIG, BIG + 2048, PW, dtraw, P.in[13], P.in[14], P.in[15], P.in[16], P.in[17], rowss, lds); __syncthreads(); }
                        PH(6) for (int it = bid; it < 2048; it += G) gmlp_item(it, BIG, P.in[10], P.in[11], P.in[12], lds);
                    }
                    GSYNC();
                    PH(7) { pg8::Gemm g{BIG, (const bf16_t*)(ws + WS_WOUT1), T, D, D, PW}; pg8::StaticOrder S; S.init(T, D, G, bid);
                      pg8::EpiResid<2, false> E{H, H, modl + 1 * 3072 + 2048, rowss}; pg8::gemm_phase(ldsl, g, S, E); }
                    PH(7) { pg8::Gemm g{BIG + 2048, (const bf16_t*)(ws + WS_WOUT2), T, D, D, PW}; pg8::StaticOrder S; S.init(T, D, G, bid);
                      pg8::EpiResid<2, true> E{H, H, modl + 1 * 3072 + 2048, rowss}; pg8::gemm_phase(ldsl, g, S, E); }
                    GSYNC();
                } else {
                    PH(1) norm_phase<false, true, false>(H, nullptr, nullptr, XN, normg + (l * 4 + 1) * D, modl + 1 * 3072, nullptr, nullptr, lds, G);
                    GSYNC();
                    PH(8) { pg8::Gemm g{XN, (const bf16_t*)(ws + WS_WQK), T, 2 * D, D, D}; pg8::StaticOrder S; S.init(T, 2 * D, G, bid);
                      pg8::EpiQK E{(bf16_t*)(ws + WS_Q), (bf16_t*)(ws + WS_K), P.in[20], P.in[21], 0.125f * LOG2E}; pg8::gemm_phase(ldsl, g, S, E); }
                    PH(8) { pg8::Gemm g{(const bf16_t*)(ws + WS_WV), XN, D, T, D, D}; pg8::StaticOrder S; S.init(D, T, G, bid);
                      pg8::EpiPlain E{(bf16_t*)(ws + WS_VT), T}; pg8::gemm_phase(ldsl, g, S, E); }
                    GSYNC();
                    PH(9) attn_phase((const bf16_t*)(ws + WS_Q), (const bf16_t*)(ws + WS_K), (const bf16_t*)(ws + WS_VT), XN, lds, G);
#ifdef REP_ATT
                    __syncthreads(); attn_phase((const bf16_t*)(ws + WS_Q), (const bf16_t*)(ws + WS_K), (const bf16_t*)(ws + WS_VT), XN, lds, G);
#endif
                    GSYNC();
                    PH(10) { pg8::Gemm g{XN, (const bf16_t*)(ws + WS_WO), T, D, D, D}; pg8::StaticOrder S; S.init(T, D, G, bid);
                      pg8::EpiResid<2, false> E{H, H, modl + 1 * 3072 + 2048, rowss}; pg8::gemm_phase(ldsl, g, S, E); }
                    GSYNC();
                }
            }
        }
    }
#ifdef REP_SYNC
    for (int r = 0; r < 20; ++r) grid.sync();
#endif
    PH(1) norm_phase<true, false, false>(H, H, normg + (1 * 4 + 3) * D, nullptr, nullptr, nullptr, nullptr, nullptr, lds, G);
}

extern "C" void kernel_launch(void* const* d_in, const int* in_sizes, int n_in, void* d_out, int out_size, void* d_ws, size_t ws_size, hipStream_t stream) {
    static int grid = 0;
    if (grid == 0) {
        if (n_in != 23 || out_size != T * D || ws_size < WS_END) { fprintf(stderr, "kernel_launch: unexpected shapes (n_in %d out %d ws %zu)\n", n_in, out_size, ws_size); grid = -1; return; }
        int dev = 0, cus = 0, per_cu = 0;
        hipGetDevice(&dev);
        hipDeviceGetAttribute(&cus, hipDeviceAttributeMultiprocessorCount, dev);
        hipFuncSetAttribute((const void*)fwd_megakernel, hipFuncAttributeMaxDynamicSharedMemorySize, LDS_BYTES);
        hipOccupancyMaxActiveBlocksPerMultiprocessor(&per_cu, (const void*)fwd_megakernel, NTHREADS, LDS_BYTES);
        if (per_cu < 1) per_cu = 1;
        grid = cus * per_cu;
        (void)hipGetLastError();
    }
    if (grid < 0) return;
    Params p{};
    for (int i = 0; i < 23; ++i) p.in[i] = (const float*)d_in[i];
    p.out = (float*)d_out; p.ws = (unsigned char*)d_ws;
    void* args[] = {&p};
    hipError_t e = hipLaunchCooperativeKernel((const void*)fwd_megakernel, dim3(grid), dim3(NTHREADS), args, LDS_BYTES, stream);
    if (e != hipSuccess) fprintf(stderr, "cooperative launch failed: %s (grid %d)\n", hipGetErrorString(e), grid);
}
```

```cpp
#include <hip/hip_runtime.h>
#include <hip/hip_cooperative_groups.h>
#include <cstdio>
#include <cstdint>
namespace cg = cooperative_groups;

#define DI __device__ __forceinline__
#define LAS __attribute__((address_space(3)))
typedef unsigned short bf16_t;
typedef short bf16x8 __attribute__((ext_vector_type(8)));
typedef float f32x4 __attribute__((ext_vector_type(4)));
typedef float f32x16 __attribute__((ext_vector_type(16)));
typedef unsigned u32x4 __attribute__((ext_vector_type(4)));
typedef unsigned u32x2 __attribute__((ext_vector_type(2)));

constexpr int T = 32768, D = 1024, FF = 2816, SEQ = 4096, NB = 8;
constexpr int INW = 4624, PW = 4608;
constexpr int MODW = 9216;
constexpr float EPS = 1e-6f;
constexpr float LOG2E = 1.4426950408889634f, LN2 = 0.6931471805599453f;
constexpr int NTHREADS = 512, NWAVES = 8;
constexpr int LDS_BYTES = 147456;

constexpr size_t MiB = 1u << 20;
constexpr size_t WS_MOD = 0;
constexpr size_t WS_ROWSS = 1 * MiB;
constexpr size_t WS_DT = 2 * MiB;
constexpr size_t WS_WGU = 4 * MiB;
constexpr size_t WS_WDN = 48 * MiB;
constexpr size_t WS_WIN = 70 * MiB;
constexpr size_t WS_WOUT1 = 79 * MiB, WS_WOUT2 = 81 * MiB;
constexpr size_t WS_WQK = 83 * MiB;
constexpr size_t WS_WV = 87 * MiB, WS_WO = 89 * MiB;
constexpr size_t WS_XN = 92 * MiB;
constexpr size_t WS_BIG = 156 * MiB;
constexpr size_t WS_Q = WS_BIG, WS_K = WS_BIG + 64 * MiB, WS_VT = WS_BIG + 128 * MiB;
constexpr size_t WS_BCC = 444 * MiB;
constexpr size_t WS_END = 476 * MiB;

DI unsigned f2bf(float f) { unsigned u = __builtin_bit_cast(unsigned, f); return (u + 0x7fffu + ((u >> 16) & 1u)) >> 16; }
typedef float f32x2_t __attribute__((ext_vector_type(2))); typedef __bf16 bf16x2_t __attribute__((ext_vector_type(2)));
DI unsigned cvt_pk_bf16(float lo, float hi) { f32x2_t v = {lo, hi}; bf16x2_t b = __builtin_convertvector(v, bf16x2_t); return __builtin_bit_cast(unsigned, b); }
DI unsigned pk2(float lo, float hi) { return cvt_pk_bf16(lo, hi); }
DI float bflo(unsigned u) { return __uint_as_float(u << 16); }
DI float bfhi(unsigned u) { return __uint_as_float(u & 0xffff0000u); }
DI float ex2(float x) { return __builtin_amdgcn_exp2f(x); }
DI float lg2(float x) { return __builtin_amdgcn_logf(x); }
DI float rcpf_(float x) { return __builtin_amdgcn_rcpf(x); }
DI float silu_f(float x) { return x * rcpf_(1.f + ex2(-x * LOG2E)); }
DI float gelu_tanh_f(float x) { const float u = 0.7978845608028654f * (x + 0.044715f * x * x * x); return x * rcpf_(1.f + ex2(-2.f * LOG2E * u)); }
DI float softplus_f(float x) { return fmaxf(x, 0.f) + LN2 * lg2(1.f + ex2(-fabsf(x) * LOG2E)); }
DI float wave_sum(float v) {
#pragma unroll
    for (int o = 1; o < 64; o <<= 1) v += __shfl_xor(v, o);
    return v;
}

namespace pg8 {
constexpr int BM = 256, BK = 64, HALF = 128, HTB = HALF * BK * 2, STAGE_BYTES = 8 * HTB, NXCD = 8, WGM = 8;
DI int lds_byte(int r, int c) { const int st = (r >> 4) * 2 + (c >> 5), rr = r & 15, cc = c & 31, ob = rr * 64 + cc * 2; return st * 1024 + (ob ^ (((ob >> 9) & 1) << 5)); }
DI void stage_rc(int b, int& R, int& C) { const int st = b / 1024, sb = b % 1024, swz = sb ^ (((sb >> 9) & 1) << 5); R = (st >> 1) * 16 + swz / 64; C = (st & 1) * 32 + (swz % 64) / 2; }
DI int perm32(int rho) { const int n = rho >> 4, i = rho & 15; return 8 * (i >> 2) + 4 * n + (i & 3); }

struct Unit { int pm, pn; };
struct Gemm { const bf16_t* A; const bf16_t* Bt; int M, N, K, lda; };

struct StaticOrder {
    int nM, nN, nwg, G, c;
    DI void init(int M, int N, int G_, int c_) { nM = M / BM; nN = N / BM; nwg = nM * nN; G = G_; c = c_; }
    DI bool next(int i, Unit& u) const {
        const long L = (long)i * G + c; if (L >= nwg) return false;
        int wgid = (int)L; { const int q = nwg / NXCD, r = nwg % NXCD, xcd = wgid % NXCD, off = wgid / NXCD; wgid = (xcd < r ? xcd * (q + 1) : r * (q + 1) + (xcd - r) * q) + off; }
        const int nig = WGM * nN, gid = wgid / nig, fm = gid * WGM, gsz = (nM - fm) < WGM ? (nM - fm) : WGM;
        u.pm = fm + ((wgid % nig) % gsz); u.pn = (wgid % nig) / gsz; return true;
    }
};

template <class Epi>
DI void gemm_phase(LAS unsigned char* lds, const Gemm g, const StaticOrder& S, const Epi& E) {
    int tid_ = threadIdx.x; asm volatile("" : "+v"(tid_));
    const int tid = tid_, wid = __builtin_amdgcn_readfirstlane(tid >> 6), lane = tid & 63, wr = wid >> 2, wc = wid & 3, fr = lane & 15, fq = lane >> 4;
    const int K = g.K, nt = K / BK, lda = g.lda;
    unsigned voffA[2], voffB[2];
#pragma unroll
    for (int i = 0; i < 2; ++i) { int R, C; stage_rc(tid * 16 + i * 8192, R, C); const int Rb = (R & ~31) + perm32(R & 31);
        voffA[i] = (unsigned)(R * lda + C) * 2u; voffB[i] = (unsigned)(Rb * K + C) * 2u; }
    const size_t kstep = (size_t)(BK * 2);
    const size_t hstepA = (size_t)HALF * lda * 2, hstepB = (size_t)HALF * K * 2;
    const size_t tstepA = 2 * hstepA, tstepB = 2 * hstepB;
    const unsigned ldsw = (unsigned)wid * 1024u;
    const int aoff = lds_byte(wr * 64 + fr, fq * 8), boff = lds_byte(wc * 32 + fr, fq * 8);
#define PG8_SA(b, h) (((b) * 2 + (h)) * HTB)
#define PG8_SB(b, h) ((4 + (b) * 2 + (h)) * HTB)
#define PG8_STAGE(bufoff, gbase, voff) do { _Pragma("unroll") for (int _i = 0; _i < 2; ++_i) \
        __builtin_amdgcn_global_load_lds((const unsigned*)((const char*)(gbase) + (voff)[_i]), (LAS unsigned*)(lds + (bufoff) + ldsw + _i * 8192), 16, 0, 0); } while (0)
#define PG8_LDA(dst, b, h) do { _Pragma("unroll") for (int m = 0; m < 4; ++m) _Pragma("unroll") for (int k = 0; k < 2; ++k) dst[m][k] = *(const LAS bf16x8*)(lds + PG8_SA(b, h) + aoff + m * 2048 + k * 1024); } while (0)
#define PG8_LDB(dst, b, h) do { _Pragma("unroll") for (int n = 0; n < 2; ++n) _Pragma("unroll") for (int k = 0; k < 2; ++k) dst[n][k] = *(const LAS bf16x8*)(lds + PG8_SB(b, h) + boff + n * 2048 + k * 1024); } while (0)
#define PG8_MMA(ai, bj, At, Bt) do { __builtin_amdgcn_s_setprio(1); _Pragma("unroll") for (int m = 0; m < 4; ++m) _Pragma("unroll") for (int n = 0; n < 2; ++n) _Pragma("unroll") for (int k = 0; k < 2; ++k) \
        acc[ai][bj][m][n] = __builtin_amdgcn_mfma_f32_16x16x32_bf16(Bt[n][k], At[m][k], acc[ai][bj][m][n], 0, 0, 0); __builtin_amdgcn_s_setprio(0); } while (0)
#define PG8_WAIT_V(n) asm volatile("s_waitcnt vmcnt(" #n ")" ::: "memory")
#define PG8_WAIT_L(n) asm volatile("s_waitcnt lgkmcnt(" #n ")" ::: "memory")
#define PG8_BAR __builtin_amdgcn_s_barrier()
#define PG8_SCHED __builtin_amdgcn_sched_barrier(0)
    Unit cur, nxt; int ui = 0;
    if (!S.next(0, cur)) return;
    f32x4 acc[2][2][4][2];
#pragma unroll
    for (int a = 0; a < 2; ++a)
#pragma unroll
        for (int b = 0; b < 2; ++b)
#pragma unroll
            for (int m = 0; m < 4; ++m)
#pragma unroll
                for (int n = 0; n < 2; ++n) acc[a][b][m][n] = (f32x4){0.f, 0.f, 0.f, 0.f};
    bf16x8 At[4][2], B0[2][2], B1[2][2];
    const char* cA = (const char*)g.A + (size_t)cur.pm * tstepA; const char* cB = (const char*)g.Bt + (size_t)cur.pn * tstepB;
    PG8_STAGE(PG8_SB(0, 0), cB, voffB); PG8_STAGE(PG8_SB(0, 1), cB + hstepB, voffB); PG8_STAGE(PG8_SA(0, 0), cA, voffA); PG8_STAGE(PG8_SA(0, 1), cA + hstepA, voffA);
    if (wr == 1) PG8_BAR;
    PG8_WAIT_V(2); PG8_BAR;
    PG8_STAGE(PG8_SB(1, 0), cB + kstep, voffB); PG8_STAGE(PG8_SA(1, 0), cA + kstep, voffA); PG8_STAGE(PG8_SB(1, 1), cB + hstepB + kstep, voffB);
    PG8_WAIT_V(6); PG8_BAR;
    for (;;) {
        const bool has_next = S.next(ui + 1, nxt);
        const char* nA = has_next ? (const char*)g.A + (size_t)nxt.pm * tstepA : cA; const char* nB = has_next ? (const char*)g.Bt + (size_t)nxt.pn * tstepB : cB;
        for (int t = 0; t < nt; t += 2) {
            const bool last = (t == nt - 2);
            const char* a1 = cA + (size_t)(t + 1) * kstep;
            const char* a2 = last ? nA : cA + (size_t)(t + 2) * kstep; const char* b2 = last ? nB : cB + (size_t)(t + 2) * kstep;
            const char* a3 = a2 + kstep; const char* b3 = b2 + kstep;
            PG8_LDB(B0, 0, 0); PG8_LDB(B1, 0, 1); PG8_SCHED; PG8_LDA(At, 0, 0); PG8_STAGE(PG8_SA(1, 1), a1 + hstepA, voffA);
            PG8_WAIT_V(8); PG8_WAIT_L(0); PG8_BAR; PG8_MMA(0, 0, At, B0); PG8_MMA(0, 1, At, B1); PG8_BAR; PG8_SCHED;
            PG8_LDA(At, 0, 1); PG8_STAGE(PG8_SB(0, 0), b2, voffB); PG8_STAGE(PG8_SB(0, 1), b2 + hstepB, voffB); PG8_STAGE(PG8_SA(0, 0), a2, voffA);
            PG8_WAIT_V(8); PG8_WAIT_L(0); PG8_BAR; PG8_MMA(1, 0, At, B0); PG8_MMA(1, 1, At, B1); PG8_BAR; PG8_SCHED;
            PG8_LDB(B0, 1, 0); PG8_LDB(B1, 1, 1); PG8_SCHED; PG8_LDA(At, 1, 0); PG8_STAGE(PG8_SA(0, 1), a2 + hstepA, voffA);
            PG8_WAIT_V(8); PG8_WAIT_L(0); PG8_BAR; PG8_MMA(0, 0, At, B0); PG8_MMA(0, 1, At, B1); PG8_BAR; PG8_SCHED;
            PG8_LDA(At, 1, 1); PG8_STAGE(PG8_SB(1, 0), b3, voffB); PG8_STAGE(PG8_SB(1, 1), b3 + hstepB, voffB); PG8_STAGE(PG8_SA(1, 0), a3, voffA);
            PG8_WAIT_V(8); PG8_WAIT_L(0); PG8_BAR; PG8_MMA(1, 0, At, B0); PG8_MMA(1, 1, At, B1); PG8_BAR; PG8_SCHED;
        }
        if (wr == 0) PG8_BAR;
        E(acc, cur, wr, wc, fr, fq);
        if (!has_next) break;
#pragma unroll
        for (int a = 0; a < 2; ++a)
#pragma unroll
            for (int b = 0; b < 2; ++b)
#pragma unroll
                for (int m = 0; m < 4; ++m)
#pragma unroll
                    for (int n = 0; n < 2; ++n) acc[a][b][m][n] = (f32x4){0.f, 0.f, 0.f, 0.f};
        cur = nxt; cA = nA; cB = nB; ++ui;
        if (wr == 1) PG8_BAR;
    }
    PG8_WAIT_V(0);
    PG8_BAR;
#undef PG8_SA
#undef PG8_SB
#undef PG8_STAGE
#undef PG8_LDA
#undef PG8_LDB
#undef PG8_MMA
#undef PG8_WAIT_V
#undef PG8_WAIT_L
#undef PG8_BAR
#undef PG8_SCHED
}

typedef f32x4 Acc[2][2][4][2];

struct EpiSwiGLU {
    bf16_t* O;
    DI void operator()(const Acc& acc, const Unit& u, int wr, int wc, int fr, int fq) const {
        const int row0 = u.pm * BM + wr * 64 + fr, col0 = u.pn * 128 + wc * 32 + 8 * fq;
#pragma unroll
        for (int ai = 0; ai < 2; ++ai)
#pragma unroll
            for (int m = 0; m < 4; ++m) {
                bf16_t* rowp = O + (size_t)(row0 + ai * HALF + m * 16) * FF + col0;
                const f32x4 g0 = acc[ai][0][m][0], g1 = acc[ai][0][m][1], u0 = acc[ai][1][m][0], u1 = acc[ai][1][m][1];
                u32x4 w;
                w.x = cvt_pk_bf16(silu_f(g0[0]) * u0[0], silu_f(g0[1]) * u0[1]); w.y = cvt_pk_bf16(silu_f(g0[2]) * u0[2], silu_f(g0[3]) * u0[3]);
                w.z = cvt_pk_bf16(silu_f(g1[0]) * u1[0], silu_f(g1[1]) * u1[1]); w.w = cvt_pk_bf16(silu_f(g1[2]) * u1[2], silu_f(g1[3]) * u1[3]);
                *(u32x4*)rowp = w;
            }
    }
};
template <int CS2, bool RS> struct EpiResid {
    const float* base; float* out; const float* gate; const float* rowss;
    DI void operator()(const Acc& acc, const Unit& u, int wr, int wc, int fr, int fq) const {
        const float* const base = this->base; float* const out = this->out; const float* const gate = this->gate; const float cscale = 0.5f * CS2; const float* const rowss = this->rowss;
        const int b = (u.pm * BM) >> 12;
        const int row0 = u.pm * BM + wr * 64 + fr, col0 = u.pn * BM + wc * 32 + 8 * fq;
        f32x4 gv[2][2];
#pragma unroll
        for (int bj = 0; bj < 2; ++bj)
#pragma unroll
            for (int n = 0; n < 2; ++n) gv[bj][n] = *(const f32x4*)(gate + (size_t)b * MODW + col0 + bj * HALF + 4 * n) * cscale;
#pragma unroll
        for (int ai = 0; ai < 2; ++ai)
#pragma unroll
            for (int m = 0; m < 4; ++m) {
                const int row = row0 + ai * HALF + m * 16;
                float rs = 1.f; if (RS) rs = rsqrtf(rowss[row] * (1.f / 1024.f) + EPS);
                const size_t off = (size_t)row * D + col0;
#pragma unroll
                for (int bj = 0; bj < 2; ++bj)
#pragma unroll
                    for (int n = 0; n < 2; ++n) { const f32x4 bs = *(const f32x4*)(base + off + bj * HALF + 4 * n);
                        *(f32x4*)(out + off + bj * HALF + 4 * n) = bs + gv[bj][n] * rs * acc[ai][bj][m][n]; }
                if (m & 1) asm volatile("" ::: "memory");
            }
    }
};
struct EpiProj {
    bf16_t* O;
    DI void operator()(const Acc& acc, const Unit& u, int wr, int wc, int fr, int fq) const {
        const int row0 = u.pm * BM + wr * 64 + fr, col0 = u.pn * BM + wc * 32 + 8 * fq;
        const bool act = u.pn < 8;
#pragma unroll
        for (int ai = 0; ai < 2; ++ai)
#pragma unroll
            for (int m = 0; m < 4; ++m) {
                bf16_t* rowp = O + (size_t)(row0 + ai * HALF + m * 16) * PW + col0;
#pragma unroll
                for (int bj = 0; bj < 2; ++bj) { f32x4 v0 = acc[ai][bj][m][0], v1 = acc[ai][bj][m][1];
                    if (act) {
#pragma unroll
                        for (int i = 0; i < 4; ++i) { v0[i] = gelu_tanh_f(v0[i]); v1[i] = gelu_tanh_f(v1[i]); } }
                    u32x4 w; w.x = cvt_pk_bf16(v0[0], v0[1]); w.y = cvt_pk_bf16(v0[2], v0[3]); w.z = cvt_pk_bf16(v1[0], v1[1]); w.w = cvt_pk_bf16(v1[2], v1[3]);
                    *(u32x4*)(rowp + bj * HALF) = w; }
            }
    }
};
struct EpiQK {
    bf16_t* Q; bf16_t* Kd; const float* qg; const float* kg; float qscale;
    DI void operator()(const Acc& acc, const Unit& u, int wr, int wc, int fr, int fq) const {
        const bool isq = u.pn < 4; const int hd = (4 * u.pn + wc) & 15;
        bf16_t* dst = isq ? Q : Kd; const float* gn = isq ? qg : kg; const float sc = isq ? qscale : 1.f;
        const int row0 = u.pm * BM + wr * 64 + fr;
#pragma unroll
        for (int ai = 0; ai < 2; ++ai)
#pragma unroll
            for (int m = 0; m < 4; ++m) {
                float ss = 0.f;
#pragma unroll
                for (int bj = 0; bj < 2; ++bj)
#pragma unroll
                    for (int n = 0; n < 2; ++n) { const f32x4 x = acc[ai][bj][m][n]; ss += (x[0] * x[0] + x[1] * x[1]) + (x[2] * x[2] + x[3] * x[3]); }
                ss += __shfl_xor(ss, 16); ss += __shfl_xor(ss, 32);
                const float rstd = rsqrtf(ss * (1.f / 64.f) + EPS);
                bf16_t* rowp = dst + (size_t)(row0 + ai * HALF + m * 16) * D + hd * 64 + 8 * fq;
#pragma unroll
                for (int bj = 0; bj < 2; ++bj) { const float rs2 = rstd * sc; const f32x4 v0 = acc[ai][bj][m][0] * rs2 * *(const f32x4*)(gn + 32 * bj + 8 * fq), v1 = acc[ai][bj][m][1] * rs2 * *(const f32x4*)(gn + 32 * bj + 8 * fq + 4);
                    u32x4 w; w.x = cvt_pk_bf16(v0[0], v0[1]); w.y = cvt_pk_bf16(v0[2], v0[3]); w.z = cvt_pk_bf16(v1[0], v1[1]); w.w = cvt_pk_bf16(v1[2], v1[3]);
                    *(u32x4*)(rowp + 32 * bj) = w; }
            }
    }
};
struct EpiPlain {
    bf16_t* O; int ldc;
    DI void operator()(const Acc& acc, const Unit& u, int wr, int wc, int fr, int fq) const {
        const int row0 = u.pm * BM + wr * 64 + fr, col0 = u.pn * BM + wc * 32 + 8 * fq;
#pragma unroll
        for (int ai = 0; ai < 2; ++ai)
#pragma unroll
            for (int m = 0; m < 4; ++m) {
                bf16_t* rowp = O + (size_t)(row0 + ai * HALF + m * 16) * ldc + col0;
#pragma unroll
                for (int bj = 0; bj < 2; ++bj) { const f32x4 v0 = acc[ai][bj][m][0], v1 = acc[ai][bj][m][1];
                    u32x4 w; w.x = cvt_pk_bf16(v0[0], v0[1]); w.y = cvt_pk_bf16(v0[2], v0[3]); w.z = cvt_pk_bf16(v1[0], v1[1]); w.w = cvt_pk_bf16(v1[2], v1[3]);
                    *(u32x4*)(rowp + bj * HALF) = w; }
            }
    }
};
}

struct TDesc { const float* src; int ld; int K; int N; bf16_t* dst; int ldt; int map; int rowadd; const float* kscale; };
DI void transpose_item(const TDesc& d, int k0, int n0, int drow, LAS float* scr, int lane) {
#pragma unroll 8
    for (int i = 0; i < 32; ++i) { const int kk = 2 * i + (lane >> 5); float v = d.src[(size_t)(k0 + kk) * d.ld + n0 + (lane & 31)]; if (d.kscale) v *= d.kscale[k0 + kk]; scr[kk * 33 + (lane & 31)] = v; }
    asm volatile("s_waitcnt lgkmcnt(0)" ::: "memory");
    const int c = lane & 7;
#pragma unroll
    for (int j = 0; j < 4; ++j) { const int n = (lane >> 3) + 8 * j; const LAS float* s = scr + (8 * c) * 33 + n;
        u32x4 o; o.x = pk2(s[0 * 33], s[1 * 33]); o.y = pk2(s[2 * 33], s[3 * 33]); o.z = pk2(s[4 * 33], s[5 * 33]); o.w = pk2(s[6 * 33], s[7 * 33]);
        *(u32x4*)(d.dst + (size_t)(drow + n) * d.ldt + k0 + 8 * c) = o; }
    asm volatile("s_waitcnt lgkmcnt(0)" ::: "memory");
}
DI void transpose_mat(const TDesc& d, int& base, int gw, int NGW, LAS float* scr, int lane) {
    const int nblk = d.N / 32, nitems = (d.K / 64) * nblk;
    int first = (gw - base) % NGW; if (first < 0) first += NGW;
    for (int it = first; it < nitems; it += NGW) {
        const int kb = it / nblk, nb = it % nblk, k0 = 64 * kb, n0 = 32 * nb;
        int drow;
        if (d.map == 0) drow = d.rowadd + n0;
        else if (d.map == 1) drow = 256 * (n0 >> 7) + (n0 & 127) + d.rowadd;
        else drow = 256 * (n0 >> 8) + 128 * ((n0 >> 5) & 1) + 32 * ((n0 >> 6) & 3);
        transpose_item(d, k0, n0, drow, scr, lane);
    }
    base = (base + nitems) % NGW;
}

struct Params { const float* in[23]; float* out; unsigned char* ws; };

DI void p0_phase(const Params& P, unsigned char* lds, int G) {
    int tid_ = threadIdx.x; asm volatile("" : "+v"(tid_));
    const int tid = tid_, lane = tid & 63, wave = tid >> 6;
    unsigned char* ws = P.ws;
    LAS float* scr = (LAS float*)((LAS unsigned char*)lds + wave * 9216);
    const int gw = blockIdx.x * NWAVES + wave, NGW = G * NWAVES;
    int base = 0;
    for (int f = 0; f < 4; ++f) {
        bf16_t* wgu = (bf16_t*)(ws + WS_WGU) + (size_t)f * 5632 * 1024;
        { TDesc d{P.in[5] + (size_t)f * D * FF, FF, D, FF, wgu, D, 1, 0, nullptr}; transpose_mat(d, base, gw, NGW, scr, lane); }
        { TDesc d{P.in[6] + (size_t)f * D * FF, FF, D, FF, wgu, D, 1, 128, nullptr}; transpose_mat(d, base, gw, NGW, scr, lane); }
        { TDesc d{P.in[7] + (size_t)f * FF * D, D, FF, D, (bf16_t*)(ws + WS_WDN) + (size_t)f * D * FF, FF, 0, 0, nullptr}; transpose_mat(d, base, gw, NGW, scr, lane); }
    }
    { TDesc d{P.in[8], INW, D, PW, (bf16_t*)(ws + WS_WIN), D, 0, 0, nullptr}; transpose_mat(d, base, gw, NGW, scr, lane); }
    { TDesc d{P.in[9], D, D, D, (bf16_t*)(ws + WS_WOUT1), D, 0, 0, nullptr}; transpose_mat(d, base, gw, NGW, scr, lane); }
    { TDesc d{P.in[9] + (size_t)D * D, D, D, D, (bf16_t*)(ws + WS_WOUT2), D, 0, 0, P.in[18]}; transpose_mat(d, base, gw, NGW, scr, lane); }
    { TDesc d{P.in[19], 3 * D, D, 2 * D, (bf16_t*)(ws + WS_WQK), D, 2, 0, nullptr}; transpose_mat(d, base, gw, NGW, scr, lane); }
    { TDesc d{P.in[19] + 2 * D, 3 * D, D, D, (bf16_t*)(ws + WS_WV), D, 0, 0, nullptr}; transpose_mat(d, base, gw, NGW, scr, lane); }
    { TDesc d{P.in[22], D, D, D, (bf16_t*)(ws + WS_WO), D, 0, 0, nullptr}; transpose_mat(d, base, gw, NGW, scr, lane); }
    float* rowss = (float*)(ws + WS_ROWSS);
    for (int i = blockIdx.x * NTHREADS + tid; i < T; i += G * NTHREADS) rowss[i] = 0.f;
    __syncthreads();
    float* sc = (float*)(lds + 81920);
    float* part = (float*)(lds + 114688);
    for (int i = tid; i < NB * D; i += NTHREADS) sc[i] = silu_f(P.in[1][i]);
    __syncthreads();
    float* mod = (float*)(ws + WS_MOD);
    for (int item = blockIdx.x; item < 288; item += G) {
        const int l = item / 144, n0 = (item % 144) * 64;
        const float* W = P.in[2] + (size_t)l * D * MODW + n0 + lane;
        float acc[8];
#pragma unroll
        for (int b = 0; b < 8; ++b) acc[b] = 0.f;
#pragma unroll 8
        for (int kk = 0; kk < 128; ++kk) { const int k = wave * 128 + kk; const float wv = W[(size_t)k * MODW];
#pragma unroll
            for (int b = 0; b < 8; ++b) acc[b] += sc[b * D + k] * wv; }
#pragma unroll
        for (int b = 0; b < 8; ++b) part[(wave * 8 + b) * 64 + lane] = acc[b];
        __syncthreads();
        { const int b = tid >> 6, col = tid & 63; float s = 0.f;
#pragma unroll
            for (int w = 0; w < 8; ++w) s += part[(w * 8 + b) * 64 + col];
            mod[(size_t)(l * 8 + b) * MODW + n0 + col] = s + P.in[3][(size_t)l * MODW + n0 + col]; }
        __syncthreads();
    }
}

template <bool PRE, bool MAIN, bool DT>
DI void norm_phase(const float* src, float* hdst, const float* gpre, bf16_t* xn, const float* g, const float* modl, float* dtraw, const float* w_in, unsigned char* lds, int G) {
    int tid_ = threadIdx.x; asm volatile("" : "+v"(tid_));
    const int tid = tid_, lane = tid & 63, wave = tid >> 6;
    const int gw = blockIdx.x * NWAVES + wave, NGW = G * NWAVES;
    float* wl = (float*)lds;
    if (DT) { for (int idx = tid; idx < 16384; idx += NTHREADS) { const int k = idx >> 4, hh = idx & 15; wl[hh * 1024 + k] = w_in[(size_t)k * INW + PW + hh]; } __syncthreads(); }
    for (int m = gw; m < T; m += NGW) {
        const f32x4* xr = (const f32x4*)(src + (size_t)m * D) + lane;
        f32x4 v[4]; float ss = 0.f;
#pragma unroll
        for (int j = 0; j < 4; ++j) { v[j] = xr[64 * j]; ss += (v[j][0] * v[j][0] + v[j][1] * v[j][1]) + (v[j][2] * v[j][2] + v[j][3] * v[j][3]); }
        if (PRE) {
            const float rstd = rsqrtf(wave_sum(ss) * (1.f / D) + EPS); ss = 0.f;
            f32x4* ho = (f32x4*)(hdst + (size_t)m * D) + lane;
#pragma unroll
            for (int j = 0; j < 4; ++j) { const f32x4 gp = ((const f32x4*)gpre)[lane + 64 * j]; v[j] = v[j] * rstd * gp; ho[64 * j] = v[j];
                ss += (v[j][0] * v[j][0] + v[j][1] * v[j][1]) + (v[j][2] * v[j][2] + v[j][3] * v[j][3]); }
        }
        if (MAIN) {
            const float rstd = rsqrtf(wave_sum(ss) * (1.f / D) + EPS);
            const int b = m >> 12;
            const f32x4* sh = (const f32x4*)(modl + (size_t)b * MODW) + lane; const f32x4* scl = (const f32x4*)(modl + (size_t)b * MODW + D) + lane;
            u32x2* o8 = (u32x2*)(xn + (size_t)m * D) + lane;
#pragma unroll
            for (int j = 0; j < 4; ++j) { const f32x4 gg = ((const f32x4*)g)[lane + 64 * j]; const f32x4 y = v[j] * rstd * gg * (scl[64 * j] + 1.f) + sh[64 * j]; v[j] = y;
                u32x2 w; w.x = pk2(y[0], y[1]); w.y = pk2(y[2], y[3]); o8[64 * j] = w; }
            if (DT) {
                float d[16];
#pragma unroll
                for (int hh = 0; hh < 16; ++hh) { float a = 0.f;
#pragma unroll
                    for (int j = 0; j < 4; ++j) { const f32x4 w4 = *(const f32x4*)(wl + hh * 1024 + 4 * (lane + 64 * j)); a += (v[j][0] * w4[0] + v[j][1] * w4[1]) + (v[j][2] * w4[2] + v[j][3] * w4[3]); }
                    d[hh] = a; if ((hh & 3) == 3) asm volatile("" ::: "memory"); }
                { const bool hb = (lane & 32) != 0;
#pragma unroll
                    for (int i = 0; i < 8; ++i) { const float keep = hb ? d[i + 8] : d[i], send = hb ? d[i] : d[i + 8]; d[i] = keep + __shfl_xor(send, 32); } }
                { const bool hb = (lane & 16) != 0;
#pragma unroll
                    for (int i = 0; i < 4; ++i) { const float keep = hb ? d[i + 4] : d[i], send = hb ? d[i] : d[i + 4]; d[i] = keep + __shfl_xor(send, 16); } }
                { const bool hb = (lane & 8) != 0;
#pragma unroll
                    for (int i = 0; i < 2; ++i) { const float keep = hb ? d[i + 2] : d[i], send = hb ? d[i] : d[i + 2]; d[i] = keep + __shfl_xor(send, 8); } }
                { const bool hb = (lane & 4) != 0; const float keep = hb ? d[1] : d[0], send = hb ? d[0] : d[1]; d[0] = keep + __shfl_xor(send, 4); }
                d[0] += __shfl_xor(d[0], 1); d[0] += __shfl_xor(d[0], 2);
                const int hh = ((lane >> 5) & 1) * 8 + ((lane >> 4) & 1) * 4 + ((lane >> 3) & 1) * 2 + ((lane >> 2) & 1);
                if ((lane & 3) == 0) dtraw[(size_t)m * 16 + hh] = d[0];
            }
        }
    }
}

DI void gmlp_item(int item, bf16_t* PROJ, const float* vg, const float* wsp, const float* bsp, unsigned char* lds) {
    int tid_ = threadIdx.x; asm volatile("" : "+v"(tid_));
    const int tid = tid_, lane = tid & 63, wave = tid >> 6, fr = lane & 15, fq = lane >> 4;
    const int b = item >> 8, blk = (item >> 3) & 31, g = item & 7;
    const int r0 = b * SEQ + blk * 128;
    bf16_t* vnT = (bf16_t*)lds;
    bf16_t* Wm = vnT + 128 * 136;
    {
        const int row = tid >> 2, q4 = tid & 3;
        const bf16_t* vp = PROJ + (size_t)(r0 + row) * PW + 1024 + g * 128 + q4 * 32;
        u32x4 raw[4];
#pragma unroll
        for (int i = 0; i < 4; ++i) raw[i] = *(const u32x4*)(vp + 8 * i);
        float f[32]; float ss = 0.f;
#pragma unroll
        for (int i = 0; i < 4; ++i)
#pragma unroll
            for (int e = 0; e < 4; ++e) { const unsigned u = raw[i][e]; f[8 * i + 2 * e] = bflo(u); f[8 * i + 2 * e + 1] = bfhi(u); }
#pragma unroll
        for (int i = 0; i < 32; ++i) ss += f[i] * f[i];
        ss += __shfl_xor(ss, 1); ss += __shfl_xor(ss, 2);
        const float rstd = rsqrtf(ss * (1.f / 128.f) + EPS);
        const float* gp = vg + g * 128 + q4 * 32;
#pragma unroll
        for (int i = 0; i < 32; ++i) vnT[(q4 * 32 + i) * 136 + row] = (bf16_t)f2bf(f[i] * rstd * gp[i]);
        const float* wp = wsp + ((size_t)g * 128 + row) * 128 + q4 * 32;
#pragma unroll
        for (int i = 0; i < 8; ++i) { f32x4 w4 = *(const f32x4*)(wp + 4 * i);
            if (row < 64 && q4 >= 2) w4 = (f32x4){0.f, 0.f, 0.f, 0.f};
            u32x2 o; o.x = pk2(w4[0], w4[1]); o.y = pk2(w4[2], w4[3]); *(u32x2*)(Wm + row * 136 + q4 * 32 + 4 * i) = o; }
    }
    __syncthreads();
    f32x4 acc[8];
#pragma unroll
    for (int ct = 0; ct < 8; ++ct) acc[ct] = (f32x4){0.f, 0.f, 0.f, 0.f};
    const int nks = (wave < 4) ? 2 : 4;
    for (int ks = 0; ks < nks; ++ks) {
        const bf16x8 af = *(const bf16x8*)(Wm + (16 * wave + fr) * 136 + 32 * ks + 8 * fq);
#pragma unroll
        for (int ct = 0; ct < 8; ++ct) { const bf16x8 bfr = *(const bf16x8*)(vnT + (16 * ct + fr) * 136 + 32 * ks + 8 * fq);
            acc[ct] = __builtin_amdgcn_mfma_f32_16x16x32_bf16(bfr, af, acc[ct], 0, 0, 0); }
    }
    {
        const int t = 16 * wave + fr; const float bias = bsp[g * 128 + t];
        bf16_t* up = PROJ + (size_t)(r0 + t) * PW + g * 128 + 4 * fq;
#pragma unroll
        for (int ct = 0; ct < 8; ++ct) { const u32x2 u2 = *(const u32x2*)(up + 16 * ct);
            u32x2 o; o.x = pk2(bflo(u2.x) * (acc[ct][0] + bias), bfhi(u2.x) * (acc[ct][1] + bias)); o.y = pk2(bflo(u2.y) * (acc[ct][2] + bias), bfhi(u2.y) * (acc[ct][3] + bias));
            *(u32x2*)(up + 16 * ct) = o; }
    }
    __syncthreads();
}


DI void conv_phase(const bf16_t* PROJ, bf16_t* XSC, bf16_t* BCC, const float* conv_w, const float* conv_b, int G) {
    int tid_ = threadIdx.x; asm volatile("" : "+v"(tid_));
    const int tid = tid_, cg8 = tid & 63, rb = tid >> 6;
    for (int item = blockIdx.x; item < 1536; item += G) {
        const int rblk = item / 3, third = item - rblk * 3;
        const int ch0 = third * 512 + cg8 * 8;
        const int t0 = rblk * 64 + rb * 8;
        const bool seq_start = ((t0 & (SEQ - 1)) == 0);
        const bf16_t* src = PROJ + (size_t)t0 * PW + 3072 + ch0;
        u32x4 raw[11];
#pragma unroll
        for (int i = 0; i < 11; ++i) raw[i] = (i < 3 && seq_start) ? (u32x4){0u, 0u, 0u, 0u} : *(const u32x4*)(src + (ptrdiff_t)(i - 3) * PW);
        bf16_t* dst = third < 2 ? XSC + (size_t)t0 * D + ch0 : BCC + (size_t)t0 * 512 + (ch0 - 1024);
        const int ldd = third < 2 ? D : 512;
        u32x4 o[8];
#pragma unroll
        for (int e = 0; e < 4; ++e) {
            const float* wp = conv_w + ch0 + 2 * e;
            const float w00 = wp[0], w01 = wp[1], w10 = wp[1536], w11 = wp[1537], w20 = wp[3072], w21 = wp[3073], w30 = wp[4608], w31 = wp[4609];
            const float b0 = conv_b[ch0 + 2 * e], b1 = conv_b[ch0 + 2 * e + 1];
#pragma unroll
            for (int i = 0; i < 8; ++i) {
                const unsigned u0 = raw[i][e], u1 = raw[i + 1][e], u2 = raw[i + 2][e], u3 = raw[i + 3][e];
                const float a0 = b0 + w00 * bflo(u0) + w10 * bflo(u1) + w20 * bflo(u2) + w30 * bflo(u3);
                const float a1 = b1 + w01 * bfhi(u0) + w11 * bfhi(u1) + w21 * bfhi(u2) + w31 * bfhi(u3);
                o[i][e] = pk2(silu_f(a0), silu_f(a1));
            }
        }
#pragma unroll
        for (int i = 0; i < 8; ++i) *(u32x4*)(dst + (size_t)i * ldd) = o[i];
    }
}

DI void ssd_item(int item, bf16_t* PROJ, bf16_t* ybase, int ldy, const float* dtraw, const bf16_t* XSC, const bf16_t* BCC, const float* dt_bias, const float* a_log, const float* dskip, float* rowss, unsigned char* lds) {
    int tid_ = threadIdx.x; asm volatile("" : "+v"(tid_));
    const int tid = tid_, lane = tid & 63, wave = tid >> 6, fr = lane & 15, fq = lane >> 4, r32 = lane & 31, hi = lane >> 5;
    const int b = item >> 4, hd = item & 15, g = hd >> 3;
    float* dtv = (float*)lds; float* csv = dtv + 4096;
    bf16_t* Cn = (bf16_t*)(lds + 32768);
    bf16_t* Bn = Cn + 64 * 136;
    bf16_t* BsT = Bn + 64 * 136;
    bf16_t* xsT = BsT + 128 * 72;
    bf16_t* Wl = xsT + 64 * 72;
    bf16_t* Hb = Wl + 64 * 72;
    const float Aneg = -__expf(a_log[hd]), dtb = dt_bias[hd], Dk = dskip[hd];
    for (int i = 0; i < 8; ++i) {
        const int t = (wave + 8 * i) * 64 + lane;
        const float raw = dtraw[(size_t)(b * SEQ + t) * 16 + hd] + dtb;
        const float dt = raw > 20.f ? raw : softplus_f(raw);
        float x = dt * Aneg;
#pragma unroll
        for (int o = 1; o < 64; o <<= 1) { const float y = __shfl_up(x, o); if (lane >= o) x += y; }
        dtv[t] = dt; csv[t] = x;
    }
    for (int idx = tid; idx < 64 * 136 / 2; idx += NTHREADS) ((unsigned*)Hb)[idx] = 0u;
    const bool active = tid < 320; const int cgp = tid % 40, rb = (tid / 40) & 7;
    const bf16_t* xcol = cgp < 8 ? XSC + (size_t)(b * SEQ) * D + hd * 64 + 8 * cgp
                                 : BCC + (size_t)(b * SEQ) * 512 + (cgp < 24 ? g * 128 + 8 * (cgp - 8) : 256 + g * 128 + 8 * (cgp - 24));
    const int ldx = cgp < 8 ? D : 512;
    f32x16 Hacc;
#pragma unroll
    for (int r = 0; r < 16; ++r) Hacc[r] = 0.f;
    u32x4 raw[8];
#define SSD_LOAD_RAW(c) do { _Pragma("unroll") for (int i = 0; i < 8; ++i) raw[i] = *(const u32x4*)(xcol + (size_t)((c) * 64 + rb * 8 + i) * ldx); } while (0)
    if (active) SSD_LOAD_RAW(0);
    __syncthreads();
    const int tt = wave >> 1, half = wave & 1;
    for (int c = 0; c < 64; ++c) {
        const int tb = c * 64;
        if (active) {
            float o[8][8];
#pragma unroll
            for (int i = 0; i < 8; ++i)
#pragma unroll
                for (int e = 0; e < 4; ++e) { o[i][2 * e] = bflo(raw[i][e]); o[i][2 * e + 1] = bfhi(raw[i][e]); }
            if (cgp < 8) {
#pragma unroll
                for (int cc = 0; cc < 8; ++cc) { u32x4 w; w.x = pk2(o[0][cc], o[1][cc]); w.y = pk2(o[2][cc], o[3][cc]); w.z = pk2(o[4][cc], o[5][cc]); w.w = pk2(o[6][cc], o[7][cc]);
                    *(u32x4*)(xsT + (8 * cgp + cc) * 72 + rb * 8) = w; }
            } else if (cgp < 24) {
                const int n0 = 8 * (cgp - 8);
                const float cse = csv[tb + 63];
                float dte[8];
#pragma unroll
                for (int i = 0; i < 8; ++i) { const int t = tb + rb * 8 + i; dte[i] = __expf(cse - csv[t]) * dtv[t]; }
#pragma unroll
                for (int i = 0; i < 8; ++i) *(u32x4*)(Bn + (rb * 8 + i) * 136 + n0) = raw[i];
#pragma unroll
                for (int cc = 0; cc < 8; ++cc) { u32x4 w; w.x = pk2(o[0][cc] * dte[0], o[1][cc] * dte[1]); w.y = pk2(o[2][cc] * dte[2], o[3][cc] * dte[3]);
                    w.z = pk2(o[4][cc] * dte[4], o[5][cc] * dte[5]); w.w = pk2(o[6][cc] * dte[6], o[7][cc] * dte[7]);
                    *(u32x4*)(BsT + (n0 + cc) * 72 + rb * 8) = w; }
            } else {
                const int n0 = 8 * (cgp - 24);
#pragma unroll
                for (int i = 0; i < 8; ++i) *(u32x4*)(Cn + (rb * 8 + i) * 136 + n0) = raw[i];
            }
            if (c < 63) SSD_LOAD_RAW(c + 1);
        }
        __syncthreads();
        const int trow = 16 * tt + fr;
        bf16_t* zrow = PROJ + (size_t)(b * SEQ + tb + trow) * PW + 2048 + hd * 64 + 4 * fq;
        u32x2 zr[2];
#pragma unroll
        for (int p2 = 0; p2 < 2; ++p2) zr[p2] = *(const u32x2*)(zrow + 16 * (2 * half + p2));
        const float cs_t = csv[tb + trow];
        bf16x8 cf[4];
#pragma unroll
        for (int ks = 0; ks < 4; ++ks) cf[ks] = *(const bf16x8*)(Cn + trow * 136 + 32 * ks + 8 * fq);
#pragma unroll
        for (int s2 = 0; s2 < 2; ++s2) {
            const int st = 2 * half + s2;
            u32x2 w; w.x = 0u; w.y = 0u;
            if (st <= tt) {
                f32x4 ga = (f32x4){0.f, 0.f, 0.f, 0.f};
#pragma unroll
                for (int ks = 0; ks < 4; ++ks) { const bf16x8 bfr = *(const bf16x8*)(Bn + (16 * st + fr) * 136 + 32 * ks + 8 * fq);
                    ga = __builtin_amdgcn_mfma_f32_16x16x32_bf16(bfr, cf[ks], ga, 0, 0, 0); }
                float wv[4];
#pragma unroll
                for (int j = 0; j < 4; ++j) { const int s = 16 * st + 4 * fq + j;
                    float val = (s <= trow) ? ga[j] * __expf(cs_t - csv[tb + s]) * dtv[tb + s] : 0.f;
                    if (s == trow) val += Dk;
                    wv[j] = val; }
                w.x = pk2(wv[0], wv[1]); w.y = pk2(wv[2], wv[3]);
            }
            *(u32x2*)(Wl + trow * 72 + 16 * st + 4 * fq) = w;
        }
        f32x4 ya[2];
#pragma unroll
        for (int p2 = 0; p2 < 2; ++p2) { ya[p2] = (f32x4){0.f, 0.f, 0.f, 0.f}; const int pt = 2 * half + p2;
#pragma unroll
            for (int ks = 0; ks < 4; ++ks) { const bf16x8 hf = *(const bf16x8*)(Hb + (16 * pt + fr) * 136 + 32 * ks + 8 * fq);
                ya[p2] = __builtin_amdgcn_mfma_f32_16x16x32_bf16(hf, cf[ks], ya[p2], 0, 0, 0); }
            ya[p2] = ya[p2] * __expf(cs_t); }
        __syncthreads();
        {
            const int nks = (tt < 2) ? 1 : 2;
            for (int ks = 0; ks < nks; ++ks) { const bf16x8 wf = *(const bf16x8*)(Wl + trow * 72 + 32 * ks + 8 * fq);
#pragma unroll
                for (int p2 = 0; p2 < 2; ++p2) { const bf16x8 xf = *(const bf16x8*)(xsT + (16 * (2 * half + p2) + fr) * 72 + 32 * ks + 8 * fq);
                    ya[p2] = __builtin_amdgcn_mfma_f32_16x16x32_bf16(xf, wf, ya[p2], 0, 0, 0); } }
            float ss = 0.f;
#pragma unroll
            for (int p2 = 0; p2 < 2; ++p2) { const float z0 = bflo(zr[p2].x), z1 = bfhi(zr[p2].x), z2 = bflo(zr[p2].y), z3 = bfhi(zr[p2].y);
                const float y0 = ya[p2][0] * silu_f(z0), y1 = ya[p2][1] * silu_f(z1), y2 = ya[p2][2] * silu_f(z2), y3 = ya[p2][3] * silu_f(z3);
                ss += (y0 * y0 + y1 * y1) + (y2 * y2 + y3 * y3);
                u32x2 o; o.x = pk2(y0, y1); o.y = pk2(y2, y3); *(u32x2*)(ybase + (size_t)(b * SEQ + tb + trow) * ldy + hd * 64 + 4 * fq + 16 * (2 * half + p2)) = o; }
            ss += __shfl_xor(ss, 16); ss += __shfl_xor(ss, 32);
            if (fq == 0) atomicAdd(rowss + (size_t)(b * SEQ + tb + trow), ss);
            const int pp = wave >> 2, nn = wave & 3;
            const float cd = __expf(csv[tb + 63]);
#pragma unroll
            for (int r = 0; r < 16; ++r) Hacc[r] *= cd;
#pragma unroll
            for (int ks = 0; ks < 4; ++ks) { const bf16x8 bf = *(const bf16x8*)(BsT + (32 * nn + r32) * 72 + 16 * ks + 8 * hi);
                const bf16x8 xf = *(const bf16x8*)(xsT + (32 * pp + r32) * 72 + 16 * ks + 8 * hi);
                Hacc = __builtin_amdgcn_mfma_f32_32x32x16_bf16(bf, xf, Hacc, 0, 0, 0); }
#pragma unroll
            for (int r4 = 0; r4 < 4; ++r4) { u32x2 o; o.x = pk2(Hacc[4 * r4], Hacc[4 * r4 + 1]); o.y = pk2(Hacc[4 * r4 + 2], Hacc[4 * r4 + 3]);
                *(u32x2*)(Hb + (32 * pp + r32) * 136 + 32 * nn + 8 * r4 + 4 * hi) = o; }
        }
        __syncthreads();
    }
#undef SSD_LOAD_RAW
}

DI int pi32(int m) { return (m & ~12) | ((m & 4) << 1) | ((m & 8) >> 1); }
DI void attn_phase(const bf16_t* Q, const bf16_t* Kg, const bf16_t* Vt, bf16_t* O, unsigned char* lds, int G) {
    int tid_ = threadIdx.x; asm volatile("" : "+v"(tid_));
    const int tid = tid_, lane = tid & 63, wave = tid >> 6, r32 = lane & 31, hi = lane >> 5;
    const int key = tid >> 3, ch = tid & 7, stoff = key * 144 + ch * 16;
    const int krow = pi32(r32);
    unsigned* aflag = (unsigned*)(lds + 36864);
    for (int v = blockIdx.x; v < 256; v += G) {
        const int bh = v >> 1, par = v & 1, b = bh >> 4, hd = bh & 15;
        const bf16_t* kgp = Kg + (size_t)(b * SEQ + key) * D + hd * 64 + 8 * ch;
        const bf16_t* vgp = Vt + (size_t)(hd * 64 + key) * T + b * SEQ + 8 * ch;
        for (int ui = 0; ui < 8; ++ui) {
            const int s_ = par * 4 + (ui >> 1), qb = (ui & 1) ? 15 - s_ : s_;
            const int q0 = qb * 256, qw = q0 + 32 * wave, NT = 4 * qb + 4, tq = qw >> 6;
            const bf16_t* qp = Q + (size_t)(b * SEQ + qw + r32) * D + hd * 64 + 8 * hi;
            bf16x8 qf[4];
#pragma unroll
            for (int d0 = 0; d0 < 4; ++d0) qf[d0] = *(const bf16x8*)(qp + 16 * d0);
            f32x16 o0, o1;
#pragma unroll
            for (int r = 0; r < 16; ++r) { o0[r] = 0.f; o1[r] = 0.f; }
            float run = 0.f;
            u32x4 kr = *(const u32x4*)(kgp + (size_t)(NT - 1) * 64 * D), vr = *(const u32x4*)(vgp + (NT - 1) * 64);
            *(u32x4*)(lds + stoff) = kr; *(u32x4*)(lds + 9216 + stoff) = vr;
            __syncthreads();
            int buf = 0;
            for (int i = NT - 1; i >= 0; --i, buf ^= 1) {
                if (i > 0) { kr = *(const u32x4*)(kgp + (size_t)(i - 1) * 64 * D); vr = *(const u32x4*)(vgp + (i - 1) * 64); }
                if (i <= tq) {
                    const unsigned char* Kl = lds + buf * 18432; const unsigned char* Vl = Kl + 9216;
                    f32x16 p[2];
#pragma unroll
                    for (int kb = 0; kb < 2; ++kb) {
#pragma unroll
                        for (int r = 0; r < 16; ++r) p[kb][r] = 0.f;
#pragma unroll
                        for (int d0 = 0; d0 < 4; ++d0) { const bf16x8 kf = *(const bf16x8*)(Kl + (32 * kb + krow) * 144 + (16 * d0 + 8 * hi) * 2);
                            p[kb] = __builtin_amdgcn_mfma_f32_32x32x16_bf16(kf, qf[d0], p[kb], 0, 0, 0); }
                    }
                    const bool masked = (i == tq);
                    float lk[2][16];
#pragma unroll
                    for (int kb = 0; kb < 2; ++kb)
#pragma unroll
                        for (int r = 0; r < 16; ++r) {
                            const float z = p[kb][r];
                            const float sp = fmaxf(z, 0.f) + lg2(1.f + ex2(-fabsf(z)));
                            float lkv = -sp, lb = z - sp;
                            if (masked) { const int ka = 64 * i + 32 * kb + 16 * (r >> 3) + 8 * hi + (r & 7); const bool valid = ka < qw + r32; lkv = valid ? lkv : 0.f; lb = valid ? lb : -INFINITY; }
                            lk[kb][r] = lkv; p[kb][r] = lb;
                        }
                    float glo[2][2], ghi[2][2];
#pragma unroll
                    for (int kb = 0; kb < 2; ++kb)
#pragma unroll
                        for (int s = 0; s < 2; ++s) { float gs = 0.f;
#pragma unroll
                            for (int j = 0; j < 8; ++j) gs += lk[kb][8 * s + j];
                            auto rr = __builtin_amdgcn_permlane32_swap(__float_as_uint(gs), __float_as_uint(gs), false, false);
                            glo[kb][s] = __uint_as_float(rr[0]); ghi[kb][s] = __uint_as_float(rr[1]); }
                    float basev = run;
#pragma unroll
                    for (int kb = 1; kb >= 0; --kb)
#pragma unroll
                        for (int s = 1; s >= 0; --s) {
                            float a = basev + (hi == 0 ? ghi[kb][s] : 0.f);
#pragma unroll
                            for (int j = 7; j >= 0; --j) { const float w = ex2(p[kb][8 * s + j] + a); a += lk[kb][8 * s + j]; p[kb][8 * s + j] = w; }
                            basev += glo[kb][s] + ghi[kb][s];
                        }
                    run = basev;
#pragma unroll
                    for (int kb = 0; kb < 2; ++kb)
#pragma unroll
                        for (int s = 0; s < 2; ++s) {
                            u32x4 pw; pw.x = cvt_pk_bf16(p[kb][8 * s + 0], p[kb][8 * s + 1]); pw.y = cvt_pk_bf16(p[kb][8 * s + 2], p[kb][8 * s + 3]);
                            pw.z = cvt_pk_bf16(p[kb][8 * s + 4], p[kb][8 * s + 5]); pw.w = cvt_pk_bf16(p[kb][8 * s + 6], p[kb][8 * s + 7]);
                            const bf16x8 pa = __builtin_bit_cast(bf16x8, pw);
                            const bf16x8 v0 = *(const bf16x8*)(Vl + (r32) * 144 + (32 * kb + 16 * s + 8 * hi) * 2);
                            const bf16x8 v1 = *(const bf16x8*)(Vl + (32 + r32) * 144 + (32 * kb + 16 * s + 8 * hi) * 2);
                            o0 = __builtin_amdgcn_mfma_f32_32x32x16_bf16(pa, v0, o0, 0, 0, 0);
                            o1 = __builtin_amdgcn_mfma_f32_32x32x16_bf16(pa, v1, o1, 0, 0, 0);
                        }
                }
                if (i > 0) { *(u32x4*)(lds + (buf ^ 1) * 18432 + stoff) = kr; *(u32x4*)(lds + (buf ^ 1) * 18432 + 9216 + stoff) = vr; }
                if (lane == 0) aflag[buf * 8 + wave] = __any(run > -100.f) ? 1u : 0u;
                __syncthreads();
                { const u32x4 f0 = *(const u32x4*)(aflag + buf * 8), f1 = *(const u32x4*)(aflag + buf * 8 + 4);
                  if (((f0.x | f0.y) | (f0.z | f0.w) | (f1.x | f1.y) | (f1.z | f1.w)) == 0u) break; }
            }
            bf16_t* op = O + (size_t)(b * SEQ + qw) * D + hd * 64 + r32;
#pragma unroll
            for (int r = 0; r < 16; ++r) { const int qrow = (r & 3) + 8 * (r >> 2) + 4 * hi;
                op[(size_t)qrow * D] = (bf16_t)f2bf(o0[r]); op[(size_t)qrow * D + 32] = (bf16_t)f2bf(o1[r]); }
        }
    }
}


#define XB_TMO      128
#define XB_XCNT(j)  (256  + 64 * (j))
#define XB_XSUB(j)  (1280 + 64 * (j))
#define XB_XGEN(j)  (2304 + 64 * (j))
#define XB_TOP      3328
#define XB_TOPGEN   3392
#define XCD_BAR_WORDS 3456
#define XB_SPIN_CAP (1u << 18)
DI unsigned xb_ld(unsigned* p)              { return __hip_atomic_load(p, __ATOMIC_RELAXED, __HIP_MEMORY_SCOPE_AGENT); }
DI unsigned xb_add(unsigned* p, unsigned v) { return __hip_atomic_fetch_add(p, v, __ATOMIC_RELAXED, __HIP_MEMORY_SCOPE_AGENT); }
DI unsigned xb_xcc_id() { return (unsigned)__builtin_amdgcn_s_getreg((3 << 11) | 20) & 0xFu; }
#define XB_SPIN(cond, bar) do { unsigned _sp = 0; while (cond) { __builtin_amdgcn_s_sleep(1); \
    if ((++_sp & 255u) == 0u) { if (xb_ld(&(bar)[XB_TMO])) break; if (_sp > XB_SPIN_CAP) { atomicAdd(&(bar)[XB_TMO], 1u); break; } } } } while (0)
struct XcdBarrier { unsigned* bar; unsigned x; volatile LAS unsigned* st; };
DI XcdBarrier xcd_barrier_post(unsigned* bar, volatile LAS unsigned* st) {
    XcdBarrier b; b.bar = bar; b.x = xb_xcc_id(); b.st = st;
    if (threadIdx.x == 0) (void)xb_add(&bar[XB_XCNT(b.x)], 1u);
    return b;
}
DI void xcd_barrier_complete(unsigned* bar, unsigned x, unsigned& nloc, unsigned& nx) {
    const unsigned G = gridDim.x * gridDim.y * gridDim.z;
    unsigned sum, cnt, mine, sp = 0u;
    for (;;) {
        sum = 0u; cnt = 0u; mine = 0u;
#pragma unroll
        for (unsigned j = 0; j < 16; ++j) { const unsigned c = xb_ld(&bar[XB_XCNT(j)]); sum += c; cnt += (c > 0u) ? 1u : 0u; mine = (j == x) ? c : mine; }
        if (sum == G) break;
        __builtin_amdgcn_s_sleep(1);
        if ((++sp & 255u) == 0u) { if (xb_ld(&bar[XB_TMO])) break; if (sp > XB_SPIN_CAP) { atomicAdd(&bar[XB_TMO], 1u); break; } }
    }
    nloc = mine > 0u ? mine : 1u; nx = cnt > 0u ? cnt : 1u;
}
DI void xcd_barrier(const XcdBarrier& b) {
    asm volatile("s_waitcnt vmcnt(0)" ::: "memory");
    __syncthreads();
    if (threadIdx.x == 0) {
        unsigned* bar = b.bar;
        __builtin_amdgcn_s_waitcnt(0);
        unsigned nloc = b.st[0], nx = b.st[1];
        if (nloc == 0u) { xcd_barrier_complete(bar, b.x, nloc, nx); b.st[0] = nloc; b.st[1] = nx; }
        const unsigned old = xb_add(&bar[XB_XSUB(b.x)], 1u);
        const unsigned gen = old / nloc;
        if (old + 1u == (gen + 1u) * nloc) {
            __builtin_amdgcn_fence(__ATOMIC_RELEASE, "agent");
            asm volatile("s_waitcnt vmcnt(0)" ::: "memory");
            const unsigned og = xb_add(&bar[XB_TOP], 1u);
            const unsigned tg = og / nx;
            if (og + 1u == (tg + 1u) * nx) xb_add(&bar[XB_TOPGEN], 1u);
            else XB_SPIN(xb_ld(&bar[XB_TOPGEN]) == tg, bar);
            __builtin_amdgcn_fence(__ATOMIC_ACQUIRE, "agent");
            xb_add(&bar[XB_XGEN(b.x)], 1u);
            asm volatile("s_waitcnt vmcnt(0)" ::: "memory");
        } else {
            XB_SPIN(xb_ld(&bar[XB_XGEN(b.x)]) == gen, bar);
            __builtin_amdgcn_fence(__ATOMIC_ACQUIRE, "agent");
            asm volatile("s_waitcnt vmcnt(0)" ::: "memory");
        }
    }
    __syncthreads();
}
#ifndef PM
#define PM 0xFFFF
#endif
#define PH(bit) if constexpr ((PM >> (bit)) & 1)
#ifdef USE_CG_SYNC
#define GSYNC() grid.sync()
#else
#define GSYNC() xcd_barrier(xbar)
#endif
__global__ void __launch_bounds__(NTHREADS, 2) fwd_megakernel(Params P) {
    extern __shared__ __attribute__((aligned(16))) unsigned char lds[];
    cg::grid_group grid = cg::this_grid();
    const int G = gridDim.x, bid = blockIdx.x;
    unsigned char* ws = P.ws;
    LAS unsigned char* ldsl = (LAS unsigned char*)lds;
    float* mod = (float*)(ws + WS_MOD);
    float* rowss = (float*)(ws + WS_ROWSS);
    float* dtraw = (float*)(ws + WS_DT);
    bf16_t* XN = (bf16_t*)(ws + WS_XN);
    bf16_t* BIG = (bf16_t*)(ws + WS_BIG);
    float* H = P.out;
    const float* normg = P.in[4];

    unsigned* barw = (unsigned*)(ws + WS_ROWSS + 512 * 1024);
    if (bid == 0) for (int i = threadIdx.x; i < XCD_BAR_WORDS; i += NTHREADS) barw[i] = 0u;
    volatile LAS unsigned* xst = (volatile LAS unsigned*)(ldsl + 147456 - 64);
    if (threadIdx.x < 2) xst[threadIdx.x] = 0u;
    PH(0) p0_phase(P, lds, G);
#ifdef REP_P0
    __syncthreads(); p0_phase(P, lds, G);
#endif
    grid.sync();
    XcdBarrier xbar = xcd_barrier_post(barw, xst);

    for (int l = 0; l < 2; ++l) {
        const float* modl = mod + (size_t)l * 8 * MODW;
        PH(1) { if (l == 0) { norm_phase<false, true, false>(P.in[0], nullptr, nullptr, XN, normg + (l * 4 + 0) * D, modl + 0 * 3072, nullptr, nullptr, lds, G);
#ifdef REP_N1
            __syncthreads(); norm_phase<false, true, false>(P.in[0], nullptr, nullptr, XN, normg + (l * 4 + 0) * D, modl + 0 * 3072, nullptr, nullptr, lds, G);
#endif
        }
        else        norm_phase<true, true, false>(H, H, normg + (0 * 4 + 3) * D, XN, normg + (l * 4 + 0) * D, modl + 0 * 3072, nullptr, nullptr, lds, G); }
        GSYNC();
        for (int i = 0; i < 2; ++i) {
            const int f = l * 2 + i;
            if (i == 1) { PH(1) norm_phase<false, true, false>(H, nullptr, nullptr, XN, normg + (l * 4 + 2) * D, modl + 2 * 3072, nullptr, nullptr, lds, G); GSYNC(); }
            PH(2) { pg8::Gemm g{XN, (const bf16_t*)(ws + WS_WGU) + (size_t)f * 5632 * 1024, T, 5632, D, D}; pg8::StaticOrder S; S.init(T, 5632, G, bid);
              pg8::EpiSwiGLU E{BIG}; pg8::gemm_phase(ldsl, g, S, E); }
#ifdef REP_GU
            if (f == 0) { __syncthreads(); pg8::Gemm g{XN, (const bf16_t*)(ws + WS_WGU) + (size_t)f * 5632 * 1024, T, 5632, D, D}; pg8::StaticOrder S; S.init(T, 5632, G, bid);
              pg8::EpiSwiGLU E{BIG}; pg8::gemm_phase(ldsl, g, S, E); }
#endif
            GSYNC();
            PH(3) { pg8::Gemm g{BIG, (const bf16_t*)(ws + WS_WDN) + (size_t)f * D * FF, T, D, FF, FF}; pg8::StaticOrder S; S.init(T, D, G, bid);
              pg8::EpiResid<1, false> E{(l == 0 && i == 0) ? P.in[0] : H, H, modl + (i == 0 ? 0 : 2) * 3072 + 2048, rowss}; pg8::gemm_phase(ldsl, g, S, E); }
            GSYNC();
            if (i == 0) {
                if (l == 0) {
                    PH(1) norm_phase<false, true, true>(H, nullptr, nullptr, XN, normg + (l * 4 + 1) * D, modl + 1 * 3072, dtraw, P.in[8], lds, G);
                    GSYNC();
                    PH(4) { pg8::Gemm g{XN, (const bf16_t*)(ws + WS_WIN), T, PW, D, D}; pg8::StaticOrder S; S.init(T, PW, G, bid);
                      pg8::EpiProj E{BIG}; pg8::gemm_phase(ldsl, g, S, E); }
                    GSYNC();
                    conv_phase(BIG, XN, (bf16_t*)(ws + WS_BCC), P.in[13], P.in[14], G);
                    GSYNC();
                    if (G >= 256) {
                        if (bid < 128) { PH(5) ssd_item(bid, BIG, BIG + 2048, PW, dtraw, XN, (const bf16_t*)(ws + WS_BCC), P.in[15], P.in[16], P.in[17], rowss, lds); }
                        else { PH(6) for (int it = bid - 128; it < 2048; it += G - 128) gmlp_item(it, BIG, P.in[10], P.in[11], P.in[12], lds); }
                    } else {
                        PH(5) for (int it = bid; it < 128; it += G) { ssd_item(it, BIG, BIG + 2048, PW, dtraw, XN, (const bf16_t*)(ws + WS_BCC), P.in[15], P.in[16], P.in[17], rowss, lds); __syncthreads(); }
                        PH(6) for (int it = bid; it < 2048; it += G) gmlp_item(it, BIG, P.in[10], P.in[11], P.in[12], lds);
                    }
                    GSYNC();
                    PH(7) { pg8::Gemm g{BIG, (const bf16_t*)(ws + WS_WOUT1), T, D, D, PW}; pg8::StaticOrder S; S.init(T, D, G, bid);
                      pg8::EpiResid<2, false> E{H, H, modl + 1 * 3072 + 2048, rowss}; pg8::gemm_phase(ldsl, g, S, E); }
                    PH(7) { pg8::Gemm g{BIG + 2048, (const bf16_t*)(ws + WS_WOUT2), T, D, D, PW}; pg8::StaticOrder S; S.init(T, D, G, bid);
                      pg8::EpiResid<2, true> E{H, H, modl + 1 * 3072 + 2048, rowss}; pg8::gemm_phase(ldsl, g, S, E); }
                    GSYNC();
                } else {
                    PH(1) norm_phase<false, true, false>(H, nullptr, nullptr, XN, normg + (l * 4 + 1) * D, modl + 1 * 3072, nullptr, nullptr, lds, G);
                    GSYNC();
                    PH(8) { pg8::Gemm g{XN, (const bf16_t*)(ws + WS_WQK), T, 2 * D, D, D}; pg8::StaticOrder S; S.init(T, 2 * D, G, bid);
                      pg8::EpiQK E{(bf16_t*)(ws + WS_Q), (bf16_t*)(ws + WS_K), P.in[20], P.in[21], 0.125f * LOG2E}; pg8::gemm_phase(ldsl, g, S, E); }
                    PH(8) { pg8::Gemm g{(const bf16_t*)(ws + WS_WV), XN, D, T, D, D}; pg8::StaticOrder S; S.init(D, T, G, bid);
                      pg8::EpiPlain E{(bf16_t*)(ws + WS_VT), T}; pg8::gemm_phase(ldsl, g, S, E); }
                    GSYNC();
                    PH(9) attn_phase((const bf16_t*)(ws + WS_Q), (const bf16_t*)(ws + WS_K), (const bf16_t*)(ws + WS_VT), XN, lds, G);
#ifdef REP_ATT
                    __syncthreads(); attn_phase((const bf16_t*)(ws + WS_Q), (const bf16_t*)(ws + WS_K), (const bf16_t*)(ws + WS_VT), XN, lds, G);
#endif
                    GSYNC();
                    PH(10) { pg8::Gemm g{XN, (const bf16_t*)(ws + WS_WO), T, D, D, D}; pg8::StaticOrder S; S.init(T, D, G, bid);
                      pg8::EpiResid<2, false> E{H, H, modl + 1 * 3072 + 2048, rowss}; pg8::gemm_phase(ldsl, g, S, E); }
                    GSYNC();
                }
            }
        }
    }
#ifdef REP_SYNC
    for (int r = 0; r < 20; ++r) grid.sync();
#endif
    PH(1) norm_phase<true, false, false>(H, H, normg + (1 * 4 + 3) * D, nullptr, nullptr, nullptr, nullptr, nullptr, lds, G);
}

extern "C" void kernel_launch(void* const* d_in, const int* in_sizes, int n_in, void* d_out, int out_size, void* d_ws, size_t ws_size, hipStream_t stream) {
    static int grid = 0;
    if (grid == 0) {
        if (n_in != 23 || out_size != T * D || ws_size < WS_END) { fprintf(stderr, "kernel_launch: unexpected shapes (n_in %d out %d ws %zu)\n", n_in, out_size, ws_size); grid = -1; return; }
        int dev = 0, cus = 0, per_cu = 0;
        hipGetDevice(&dev);
        hipDeviceGetAttribute(&cus, hipDeviceAttributeMultiprocessorCount, dev);
        hipFuncSetAttribute((const void*)fwd_megakernel, hipFuncAttributeMaxDynamicSharedMemorySize, LDS_BYTES);
        hipOccupancyMaxActiveBlocksPerMultiprocessor(&per_cu, (const void*)fwd_megakernel, NTHREADS, LDS_BYTES);
        if (per_cu < 1) per_cu = 1;
        grid = cus * per_cu;
        (void)hipGetLastError();
    }
    if (grid < 0) return;
    Params p{};
    for (int i = 0; i < 23; ++i) p.in[i] = (const float*)d_in[i];
    p.out = (float*)d_out; p.ws = (unsigned char*)d_ws;
    void* args[] = {&p};
    hipError_t e = hipLaunchCooperativeKernel((const void*)fwd_megakernel, dim3(grid), dim3(NTHREADS), args, LDS_BYTES, stream);
    if (e != hipSuccess) fprintf(stderr, "cooperative launch failed: %s (grid %d)\n", hipGetErrorString(e), grid);
}
```

```cpp
#include <hip/hip_runtime.h>
#include <hip/hip_cooperative_groups.h>
#include <cstdio>
#include <cstdint>
namespace cg = cooperative_groups;

#define DI __device__ __forceinline__
#define LAS __attribute__((address_space(3)))
typedef unsigned short bf16_t;
typedef short bf16x8 __attribute__((ext_vector_type(8)));
typedef float f32x4 __attribute__((ext_vector_type(4)));
typedef float f32x16 __attribute__((ext_vector_type(16)));
typedef unsigned u32x4 __attribute__((ext_vector_type(4)));
typedef unsigned u32x2 __attribute__((ext_vector_type(2)));

constexpr int T = 32768, D = 1024, FF = 2816, SEQ = 4096, NB = 8;
constexpr int INW = 4624, PW = 4608;
constexpr int MODW = 9216;
constexpr float EPS = 1e-6f;
constexpr float LOG2E = 1.4426950408889634f, LN2 = 0.6931471805599453f;
constexpr int NTHREADS = 512, NWAVES = 8;
constexpr int LDS_BYTES = 147456;

constexpr size_t MiB = 1u << 20;
constexpr size_t WS_MOD = 0;
constexpr size_t WS_ROWSS = 1 * MiB;
constexpr size_t WS_DT = 2 * MiB;
constexpr size_t WS_WGU = 4 * MiB;
constexpr size_t WS_WDN = 48 * MiB;
constexpr size_t WS_WIN = 70 * MiB;
constexpr size_t WS_WOUT1 = 79 * MiB, WS_WOUT2 = 81 * MiB;
constexpr size_t WS_WQK = 83 * MiB;
constexpr size_t WS_WV = 87 * MiB, WS_WO = 89 * MiB;
constexpr size_t WS_XN = 92 * MiB;
constexpr size_t WS_BIG = 156 * MiB;
constexpr size_t WS_Q = WS_BIG, WS_K = WS_BIG + 64 * MiB, WS_VT = WS_BIG + 128 * MiB;
constexpr size_t WS_BCC = 444 * MiB;
constexpr size_t WS_END = 476 * MiB;

DI unsigned f2bf(float f) { unsigned u = __builtin_bit_cast(unsigned, f); return (u + 0x7fffu + ((u >> 16) & 1u)) >> 16; }
typedef float f32x2_t __attribute__((ext_vector_type(2))); typedef __bf16 bf16x2_t __attribute__((ext_vector_type(2)));
DI unsigned cvt_pk_bf16(float lo, float hi) { f32x2_t v = {lo, hi}; bf16x2_t b = __builtin_convertvector(v, bf16x2_t); return __builtin_bit_cast(unsigned, b); }
DI unsigned pk2(float lo, float hi) { return cvt_pk_bf16(lo, hi); }
DI float bflo(unsigned u) { return __uint_as_float(u << 16); }
DI float bfhi(unsigned u) { return __uint_as_float(u & 0xffff0000u); }
DI float ex2(float x) { return __builtin_amdgcn_exp2f(x); }
DI float lg2(float x) { return __builtin_amdgcn_logf(x); }
DI float rcpf_(float x) { return __builtin_amdgcn_rcpf(x); }
DI float silu_f(float x) { return x * rcpf_(1.f + ex2(-x * LOG2E)); }
DI float gelu_tanh_f(float x) { const float u = 0.7978845608028654f * (x + 0.044715f * x * x * x); return x * rcpf_(1.f + ex2(-2.f * LOG2E * u)); }
DI float softplus_f(float x) { return fmaxf(x, 0.f) + LN2 * lg2(1.f + ex2(-fabsf(x) * LOG2E)); }
DI float wave_sum(float v) {
#pragma unroll
    for (int o = 1; o < 64; o <<= 1) v += __shfl_xor(v, o);
    return v;
}

namespace pg8 {
constexpr int BM = 256, BK = 64, HALF = 128, HTB = HALF * BK * 2, STAGE_BYTES = 8 * HTB, NXCD = 8, WGM = 8;
DI int lds_byte(int r, int c) { const int st = (r >> 4) * 2 + (c >> 5), rr = r & 15, cc = c & 31, ob = rr * 64 + cc * 2; return st * 1024 + (ob ^ (((ob >> 9) & 1) << 5)); }
DI void stage_rc(int b, int& R, int& C) { const int st = b / 1024, sb = b % 1024, swz = sb ^ (((sb >> 9) & 1) << 5); R = (st >> 1) * 16 + swz / 64; C = (st & 1) * 32 + (swz % 64) / 2; }
DI int perm32(int rho) { const int n = rho >> 4, i = rho & 15; return 8 * (i >> 2) + 4 * n + (i & 3); }

struct Unit { int pm, pn; };
struct Gemm { const bf16_t* A; const bf16_t* Bt; int M, N, K, lda; int jt; long jbytes; const float* rs; };

struct StaticOrder {
    int nM, nN, nwg, G, c;
    DI void init(int M, int N, int G_, int c_) { nM = M / BM; nN = N / BM; nwg = nM * nN; G = G_; c = c_; }
    DI bool next(int i, Unit& u) const {
        const long L = (long)i * G + c; if (L >= nwg) return false;
        int wgid = (int)L; { const int q = nwg / NXCD, r = nwg % NXCD, xcd = wgid % NXCD, off = wgid / NXCD; wgid = (xcd < r ? xcd * (q + 1) : r * (q + 1) + (xcd - r) * q) + off; }
        const int nig = WGM * nN, gid = wgid / nig, fm = gid * WGM, gsz = (nM - fm) < WGM ? (nM - fm) : WGM;
        u.pm = fm + ((wgid % nig) % gsz); u.pn = (wgid % nig) / gsz; return true;
    }
};

template <class Epi>
DI void gemm_phase(LAS unsigned char* lds, const Gemm g, const StaticOrder& S, const Epi& E) {
    int tid_ = threadIdx.x; asm volatile("" : "+v"(tid_));
    const int tid = tid_, wid = __builtin_amdgcn_readfirstlane(tid >> 6), lane = tid & 63, wr = wid >> 2, wc = wid & 3, fr = lane & 15, fq = lane >> 4;
    const int K = g.K, nt = K / BK, lda = g.lda;
    unsigned voffA[2], voffB[2];
#pragma unroll
    for (int i = 0; i < 2; ++i) { int R, C; stage_rc(tid * 16 + i * 8192, R, C); const int Rb = (R & ~31) + perm32(R & 31);
        voffA[i] = (unsigned)(R * lda + C) * 2u; voffB[i] = (unsigned)(Rb * K + C) * 2u; }
    const size_t kstep = (size_t)(BK * 2);
    const size_t hstepA = (size_t)HALF * lda * 2, hstepB = (size_t)HALF * K * 2;
    const size_t tstepA = 2 * hstepA, tstepB = 2 * hstepB;
    const unsigned ldsw = (unsigned)wid * 1024u;
    const int aoff = lds_byte(wr * 64 + fr, fq * 8), boff = lds_byte(wc * 32 + fr, fq * 8);
#define PG8_SA(b, h) (((b) * 2 + (h)) * HTB)
#define PG8_SB(b, h) ((4 + (b) * 2 + (h)) * HTB)
#define PG8_STAGE(bufoff, gbase, voff) do { _Pragma("unroll") for (int _i = 0; _i < 2; ++_i) \
        __builtin_amdgcn_global_load_lds((const unsigned*)((const char*)(gbase) + (voff)[_i]), (LAS unsigned*)(lds + (bufoff) + ldsw + _i * 8192), 16, 0, 0); } while (0)
#define PG8_LDA(dst, b, h) do { _Pragma("unroll") for (int m = 0; m < 4; ++m) _Pragma("unroll") for (int k = 0; k < 2; ++k) dst[m][k] = *(const LAS bf16x8*)(lds + PG8_SA(b, h) + aoff + m * 2048 + k * 1024); } while (0)
#define PG8_LDB(dst, b, h) do { _Pragma("unroll") for (int n = 0; n < 2; ++n) _Pragma("unroll") for (int k = 0; k < 2; ++k) dst[n][k] = *(const LAS bf16x8*)(lds + PG8_SB(b, h) + boff + n * 2048 + k * 1024); } while (0)
#define PG8_MMA(ai, bj, At, Bt) do { __builtin_amdgcn_s_setprio(1); _Pragma("unroll") for (int m = 0; m < 4; ++m) _Pragma("unroll") for (int n = 0; n < 2; ++n) _Pragma("unroll") for (int k = 0; k < 2; ++k) \
        acc[ai][bj][m][n] = __builtin_amdgcn_mfma_f32_16x16x32_bf16(Bt[n][k], At[m][k], acc[ai][bj][m][n], 0, 0, 0); __builtin_amdgcn_s_setprio(0); } while (0)
#define PG8_WAIT_V(n) asm volatile("s_waitcnt vmcnt(" #n ")" ::: "memory")
#define PG8_WAIT_L(n) asm volatile("s_waitcnt lgkmcnt(" #n ")" ::: "memory")
#define PG8_BAR __builtin_amdgcn_s_barrier()
#define PG8_SCHED __builtin_amdgcn_sched_barrier(0)
    Unit cur, nxt; int ui = 0;
    if (!S.next(0, cur)) return;
    f32x4 acc[2][2][4][2];
#pragma unroll
    for (int a = 0; a < 2; ++a)
#pragma unroll
        for (int b = 0; b < 2; ++b)
#pragma unroll
            for (int m = 0; m < 4; ++m)
#pragma unroll
                for (int n = 0; n < 2; ++n) acc[a][b][m][n] = (f32x4){0.f, 0.f, 0.f, 0.f};
    bf16x8 At[4][2], B0[2][2], B1[2][2];
    const char* cA = (const char*)g.A + (size_t)cur.pm * tstepA; const char* cB = (const char*)g.Bt + (size_t)cur.pn * tstepB;
    PG8_STAGE(PG8_SB(0, 0), cB, voffB); PG8_STAGE(PG8_SB(0, 1), cB + hstepB, voffB); PG8_STAGE(PG8_SA(0, 0), cA, voffA); PG8_STAGE(PG8_SA(0, 1), cA + hstepA, voffA);
    if (wr == 1) PG8_BAR;
    PG8_WAIT_V(2); PG8_BAR;
    PG8_STAGE(PG8_SB(1, 0), cB + kstep, voffB); PG8_STAGE(PG8_SA(1, 0), cA + kstep, voffA); PG8_STAGE(PG8_SB(1, 1), cB + hstepB + kstep, voffB);
    PG8_WAIT_V(6); PG8_BAR;
    for (;;) {
        const bool has_next = S.next(ui + 1, nxt);
        const char* nA = has_next ? (const char*)g.A + (size_t)nxt.pm * tstepA : cA; const char* nB = has_next ? (const char*)g.Bt + (size_t)nxt.pn * tstepB : cB;
        for (int t = 0; t < nt; t += 2) {
            const bool last = (t == nt - 2);
            if (t == g.jt) {
#pragma unroll
                for (int a = 0; a < 2; ++a)
#pragma unroll
                    for (int m = 0; m < 4; ++m) { const float rsv = rsqrtf(g.rs[cur.pm * BM + a * HALF + wr * 64 + m * 16 + fr] * (1.f / 1024.f) + EPS);
#pragma unroll
                        for (int b = 0; b < 2; ++b)
#pragma unroll
                            for (int n = 0; n < 2; ++n) acc[a][b][m][n] = acc[a][b][m][n] * rsv; }
            }
            const char* a1 = cA + (size_t)(t + 1) * kstep + ((t + 1 >= g.jt) ? g.jbytes : 0);
            const char* a2 = last ? nA : cA + (size_t)(t + 2) * kstep + ((t + 2 >= g.jt) ? g.jbytes : 0); const char* b2 = last ? nB : cB + (size_t)(t + 2) * kstep;
            const char* a3 = a2 + kstep; const char* b3 = b2 + kstep;
            PG8_LDB(B0, 0, 0); PG8_LDB(B1, 0, 1); PG8_SCHED; PG8_LDA(At, 0, 0); PG8_STAGE(PG8_SA(1, 1), a1 + hstepA, voffA);
            PG8_WAIT_V(8); PG8_WAIT_L(0); PG8_BAR; PG8_MMA(0, 0, At, B0); PG8_MMA(0, 1, At, B1); PG8_BAR; PG8_SCHED;
            PG8_LDA(At, 0, 1); PG8_STAGE(PG8_SB(0, 0), b2, voffB); PG8_STAGE(PG8_SB(0, 1), b2 + hstepB, voffB); PG8_STAGE(PG8_SA(0, 0), a2, voffA);
            PG8_WAIT_V(8); PG8_WAIT_L(0); PG8_BAR; PG8_MMA(1, 0, At, B0); PG8_MMA(1, 1, At, B1); PG8_BAR; PG8_SCHED;
            PG8_LDB(B0, 1, 0); PG8_LDB(B1, 1, 1); PG8_SCHED; PG8_LDA(At, 1, 0); PG8_STAGE(PG8_SA(0, 1), a2 + hstepA, voffA);
            PG8_WAIT_V(8); PG8_WAIT_L(0); PG8_BAR; PG8_MMA(0, 0, At, B0); PG8_MMA(0, 1, At, B1); PG8_BAR; PG8_SCHED;
            PG8_LDA(At, 1, 1); PG8_STAGE(PG8_SB(1, 0), b3, voffB); PG8_STAGE(PG8_SB(1, 1), b3 + hstepB, voffB); PG8_STAGE(PG8_SA(1, 0), a3, voffA);
            PG8_WAIT_V(8); PG8_WAIT_L(0); PG8_BAR; PG8_MMA(1, 0, At, B0); PG8_MMA(1, 1, At, B1); PG8_BAR; PG8_SCHED;
        }
        if (wr == 0) PG8_BAR;
        E(acc, cur, wr, wc, fr, fq);
        if (!has_next) break;
#pragma unroll
        for (int a = 0; a < 2; ++a)
#pragma unroll
            for (int b = 0; b < 2; ++b)
#pragma unroll
                for (int m = 0; m < 4; ++m)
#pragma unroll
                    for (int n = 0; n < 2; ++n) acc[a][b][m][n] = (f32x4){0.f, 0.f, 0.f, 0.f};
        cur = nxt; cA = nA; cB = nB; ++ui;
        if (wr == 1) PG8_BAR;
    }
    PG8_WAIT_V(0);
    PG8_BAR;
#undef PG8_SA
#undef PG8_SB
#undef PG8_STAGE
#undef PG8_LDA
#undef PG8_LDB
#undef PG8_MMA
#undef PG8_WAIT_V
#undef PG8_WAIT_L
#undef PG8_BAR
#undef PG8_SCHED
}

typedef f32x4 Acc[2][2][4][2];

struct EpiSwiGLU {
    bf16_t* O;
    DI void operator()(const Acc& acc, const Unit& u, int wr, int wc, int fr, int fq) const {
        const int row0 = u.pm * BM + wr * 64 + fr, col0 = u.pn * 128 + wc * 32 + 8 * fq;
#pragma unroll
        for (int ai = 0; ai < 2; ++ai)
#pragma unroll
            for (int m = 0; m < 4; ++m) {
                bf16_t* rowp = O + (size_t)(row0 + ai * HALF + m * 16) * FF + col0;
                const f32x4 g0 = acc[ai][0][m][0], g1 = acc[ai][0][m][1], u0 = acc[ai][1][m][0], u1 = acc[ai][1][m][1];
                u32x4 w;
                w.x = cvt_pk_bf16(silu_f(g0[0]) * u0[0], silu_f(g0[1]) * u0[1]); w.y = cvt_pk_bf16(silu_f(g0[2]) * u0[2], silu_f(g0[3]) * u0[3]);
                w.z = cvt_pk_bf16(silu_f(g1[0]) * u1[0], silu_f(g1[1]) * u1[1]); w.w = cvt_pk_bf16(silu_f(g1[2]) * u1[2], silu_f(g1[3]) * u1[3]);
                *(u32x4*)rowp = w;
            }
    }
};
template <int CS2, bool RS> struct EpiResid {
    const float* base; float* out; const float* gate; const float* rowss;
    DI void operator()(const Acc& acc, const Unit& u, int wr, int wc, int fr, int fq) const {
        const float* const base = this->base; float* const out = this->out; const float* const gate = this->gate; const float cscale = 0.5f * CS2; const float* const rowss = this->rowss;
        const int b = (u.pm * BM) >> 12;
        const int row0 = u.pm * BM + wr * 64 + fr, col0 = u.pn * BM + wc * 32 + 8 * fq;
        f32x4 gv[2][2];
#pragma unroll
        for (int bj = 0; bj < 2; ++bj)
#pragma unroll
            for (int n = 0; n < 2; ++n) gv[bj][n] = *(const f32x4*)(gate + (size_t)b * MODW + col0 + bj * HALF + 4 * n) * cscale;
#pragma unroll
        for (int ai = 0; ai < 2; ++ai)
#pragma unroll
            for (int m = 0; m < 4; ++m) {
                const int row = row0 + ai * HALF + m * 16;
                float rs = 1.f; if (RS) rs = rsqrtf(rowss[row] * (1.f / 1024.f) + EPS);
                const size_t off = (size_t)row * D + col0;
#pragma unroll
                for (int bj = 0; bj < 2; ++bj)
#pragma unroll
                    for (int n = 0; n < 2; ++n) { const f32x4 bs = *(const f32x4*)(base + off + bj * HALF + 4 * n);
                        *(f32x4*)(out + off + bj * HALF + 4 * n) = bs + gv[bj][n] * rs * acc[ai][bj][m][n]; }
                if (m & 1) asm volatile("" ::: "memory");
            }
    }
};
struct EpiProj {
    bf16_t* O;
    DI void operator()(const Acc& acc, const Unit& u, int wr, int wc, int fr, int fq) const {
        const int row0 = u.pm * BM + wr * 64 + fr, col0 = u.pn * BM + wc * 32 + 8 * fq;
        const bool act = u.pn < 8;
#pragma unroll
        for (int ai = 0; ai < 2; ++ai)
#pragma unroll
            for (int m = 0; m < 4; ++m) {
                bf16_t* rowp = O + (size_t)(row0 + ai * HALF + m * 16) * PW + col0;
#pragma unroll
                for (int bj = 0; bj < 2; ++bj) { f32x4 v0 = acc[ai][bj][m][0], v1 = acc[ai][bj][m][1];
                    if (act) {
#pragma unroll
                        for (int i = 0; i < 4; ++i) { v0[i] = gelu_tanh_f(v0[i]); v1[i] = gelu_tanh_f(v1[i]); } }
                    u32x4 w; w.x = cvt_pk_bf16(v0[0], v0[1]); w.y = cvt_pk_bf16(v0[2], v0[3]); w.z = cvt_pk_bf16(v1[0], v1[1]); w.w = cvt_pk_bf16(v1[2], v1[3]);
                    *(u32x4*)(rowp + bj * HALF) = w; }
            }
    }
};
struct EpiQK {
    bf16_t* Q; bf16_t* Kd; const float* qg; const float* kg; float qscale;
    DI void operator()(const Acc& acc, const Unit& u, int wr, int wc, int fr, int fq) const {
        const bool isq = u.pn < 4; const int hd = (4 * u.pn + wc) & 15;
        bf16_t* dst = isq ? Q : Kd; const float* gn = isq ? qg : kg; const float sc = isq ? qscale : 1.f;
        const int row0 = u.pm * BM + wr * 64 + fr;
#pragma unroll
        for (int ai = 0; ai < 2; ++ai)
#pragma unroll
            for (int m = 0; m < 4; ++m) {
                float ss = 0.f;
#pragma unroll
                for (int bj = 0; bj < 2; ++bj)
#pragma unroll
                    for (int n = 0; n < 2; ++n) { const f32x4 x = acc[ai][bj][m][n]; ss += (x[0] * x[0] + x[1] * x[1]) + (x[2] * x[2] + x[3] * x[3]); }
                ss += __shfl_xor(ss, 16); ss += __shfl_xor(ss, 32);
                const float rstd = rsqrtf(ss * (1.f / 64.f) + EPS);
                bf16_t* rowp = dst + (size_t)(row0 + ai * HALF + m * 16) * D + hd * 64 + 8 * fq;
#pragma unroll
                for (int bj = 0; bj < 2; ++bj) { const float rs2 = rstd * sc; const f32x4 v0 = acc[ai][bj][m][0] * rs2 * *(const f32x4*)(gn + 32 * bj + 8 * fq), v1 = acc[ai][bj][m][1] * rs2 * *(const f32x4*)(gn + 32 * bj + 8 * fq + 4);
                    u32x4 w; w.x = cvt_pk_bf16(v0[0], v0[1]); w.y = cvt_pk_bf16(v0[2], v0[3]); w.z = cvt_pk_bf16(v1[0], v1[1]); w.w = cvt_pk_bf16(v1[2], v1[3]);
                    *(u32x4*)(rowp + 32 * bj) = w; }
            }
    }
};
struct EpiPlain {
    bf16_t* O; int ldc;
    DI void operator()(const Acc& acc, const Unit& u, int wr, int wc, int fr, int fq) const {
        const int row0 = u.pm * BM + wr * 64 + fr, col0 = u.pn * BM + wc * 32 + 8 * fq;
#pragma unroll
        for (int ai = 0; ai < 2; ++ai)
#pragma unroll
            for (int m = 0; m < 4; ++m) {
                bf16_t* rowp = O + (size_t)(row0 + ai * HALF + m * 16) * ldc + col0;
#pragma unroll
                for (int bj = 0; bj < 2; ++bj) { const f32x4 v0 = acc[ai][bj][m][0], v1 = acc[ai][bj][m][1];
                    u32x4 w; w.x = cvt_pk_bf16(v0[0], v0[1]); w.y = cvt_pk_bf16(v0[2], v0[3]); w.z = cvt_pk_bf16(v1[0], v1[1]); w.w = cvt_pk_bf16(v1[2], v1[3]);
                    *(u32x4*)(rowp + bj * HALF) = w; }
            }
    }
};
}

struct TDesc { const float* src; int ld; int K; int N; bf16_t* dst; int ldt; int map; int rowadd; const float* kscale; };
DI void transpose_item(const TDesc& d, int k0, int n0, int drow, LAS float* scr, int lane) {
#pragma unroll 8
    for (int i = 0; i < 32; ++i) { const int kk = 2 * i + (lane >> 5); float v = d.src[(size_t)(k0 + kk) * d.ld + n0 + (lane & 31)]; if (d.kscale) v *= d.kscale[k0 + kk]; scr[kk * 33 + (lane & 31)] = v; }
    asm volatile("s_waitcnt lgkmcnt(0)" ::: "memory");
    const int c = lane & 7;
#pragma unroll
    for (int j = 0; j < 4; ++j) { const int n = (lane >> 3) + 8 * j; const LAS float* s = scr + (8 * c) * 33 + n;
        u32x4 o; o.x = pk2(s[0 * 33], s[1 * 33]); o.y = pk2(s[2 * 33], s[3 * 33]); o.z = pk2(s[4 * 33], s[5 * 33]); o.w = pk2(s[6 * 33], s[7 * 33]);
        *(u32x4*)(d.dst + (size_t)(drow + n) * d.ldt + k0 + 8 * c) = o; }
    asm volatile("s_waitcnt lgkmcnt(0)" ::: "memory");
}
DI void transpose_mat(const TDesc& d, int& base, int gw, int NGW, LAS float* scr, int lane) {
    const int nblk = d.N / 32, nitems = (d.K / 64) * nblk;
    int first = (gw - base) % NGW; if (first < 0) first += NGW;
    for (int it = first; it < nitems; it += NGW) {
        const int kb = it / nblk, nb = it % nblk, k0 = 64 * kb, n0 = 32 * nb;
        int drow;
        if (d.map == 0) drow = d.rowadd + n0;
        else if (d.map == 1) drow = 256 * (n0 >> 7) + (n0 & 127) + d.rowadd;
        else drow = 256 * (n0 >> 8) + 128 * ((n0 >> 5) & 1) + 32 * ((n0 >> 6) & 3);
        transpose_item(d, k0, n0, drow, scr, lane);
    }
    base = (base + nitems) % NGW;
}

struct Params { const float* in[23]; float* out; unsigned char* ws; };

DI void p0_phase(const Params& P, unsigned char* lds, int G) {
    int tid_ = threadIdx.x; asm volatile("" : "+v"(tid_));
    const int tid = tid_, lane = tid & 63, wave = tid >> 6;
    unsigned char* ws = P.ws;
    LAS float* scr = (LAS float*)((LAS unsigned char*)lds + wave * 9216);
    const int gw = blockIdx.x * NWAVES + wave, NGW = G * NWAVES;
    int base = 0;
    for (int f = 0; f < 4; ++f) {
        bf16_t* wgu = (bf16_t*)(ws + WS_WGU) + (size_t)f * 5632 * 1024;
        { TDesc d{P.in[5] + (size_t)f * D * FF, FF, D, FF, wgu, D, 1, 0, nullptr}; transpose_mat(d, base, gw, NGW, scr, lane); }
        { TDesc d{P.in[6] + (size_t)f * D * FF, FF, D, FF, wgu, D, 1, 128, nullptr}; transpose_mat(d, base, gw, NGW, scr, lane); }
        { TDesc d{P.in[7] + (size_t)f * FF * D, D, FF, D, (bf16_t*)(ws + WS_WDN) + (size_t)f * D * FF, FF, 0, 0, nullptr}; transpose_mat(d, base, gw, NGW, scr, lane); }
    }
    { TDesc d{P.in[8], INW, D, PW, (bf16_t*)(ws + WS_WIN), D, 0, 0, nullptr}; transpose_mat(d, base, gw, NGW, scr, lane); }
    { TDesc d{P.in[9], D, D, D, (bf16_t*)(ws + WS_WOUT1) + D, 2 * D, 0, 0, nullptr}; transpose_mat(d, base, gw, NGW, scr, lane); }
    { TDesc d{P.in[9] + (size_t)D * D, D, D, D, (bf16_t*)(ws + WS_WOUT1), 2 * D, 0, 0, P.in[18]}; transpose_mat(d, base, gw, NGW, scr, lane); }
    { TDesc d{P.in[19], 3 * D, D, 2 * D, (bf16_t*)(ws + WS_WQK), D, 2, 0, nullptr}; transpose_mat(d, base, gw, NGW, scr, lane); }
    { TDesc d{P.in[19] + 2 * D, 3 * D, D, D, (bf16_t*)(ws + WS_WV), D, 0, 0, nullptr}; transpose_mat(d, base, gw, NGW, scr, lane); }
    { TDesc d{P.in[22], D, D, D, (bf16_t*)(ws + WS_WO), D, 0, 0, nullptr}; transpose_mat(d, base, gw, NGW, scr, lane); }
    float* rowss = (float*)(ws + WS_ROWSS);
    for (int i = blockIdx.x * NTHREADS + tid; i < T; i += G * NTHREADS) rowss[i] = 0.f;
    __syncthreads();
    float* sc = (float*)(lds + 81920);
    float* part = (float*)(lds + 114688);
    for (int i = tid; i < NB * D; i += NTHREADS) sc[i] = silu_f(P.in[1][i]);
    __syncthreads();
    float* mod = (float*)(ws + WS_MOD);
    for (int item = blockIdx.x; item < 288; item += G) {
        const int l = item / 144, n0 = (item % 144) * 64;
        const float* W = P.in[2] + (size_t)l * D * MODW + n0 + lane;
        float acc[8];
#pragma unroll
        for (int b = 0; b < 8; ++b) acc[b] = 0.f;
#pragma unroll 8
        for (int kk = 0; kk < 128; ++kk) { const int k = wave * 128 + kk; const float wv = W[(size_t)k * MODW];
#pragma unroll
            for (int b = 0; b < 8; ++b) acc[b] += sc[b * D + k] * wv; }
#pragma unroll
        for (int b = 0; b < 8; ++b) part[(wave * 8 + b) * 64 + lane] = acc[b];
        __syncthreads();
        { const int b = tid >> 6, col = tid & 63; float s = 0.f;
#pragma unroll
            for (int w = 0; w < 8; ++w) s += part[(w * 8 + b) * 64 + col];
            mod[(size_t)(l * 8 + b) * MODW + n0 + col] = s + P.in[3][(size_t)l * MODW + n0 + col]; }
        __syncthreads();
    }
}

template <bool PRE, bool MAIN, bool DT>
DI void norm_phase(const float* src, float* hdst, const float* gpre, bf16_t* xn, const float* g, const float* modl, float* dtraw, const float* w_in, unsigned char* lds, int G) {
    int tid_ = threadIdx.x; asm volatile("" : "+v"(tid_));
    const int tid = tid_, lane = tid & 63, wave = tid >> 6;
    const int gw = blockIdx.x * NWAVES + wave, NGW = G * NWAVES;
    float* wl = (float*)lds;
    if (DT) { for (int idx = tid; idx < 16384; idx += NTHREADS) { const int k = idx >> 4, hh = idx & 15; wl[hh * 1024 + k] = w_in[(size_t)k * INW + PW + hh]; } __syncthreads(); }
    for (int m = gw; m < T; m += NGW) {
        const f32x4* xr = (const f32x4*)(src + (size_t)m * D) + lane;
        f32x4 v[4]; float ss = 0.f;
#pragma unroll
        for (int j = 0; j < 4; ++j) { v[j] = xr[64 * j]; ss += (v[j][0] * v[j][0] + v[j][1] * v[j][1]) + (v[j][2] * v[j][2] + v[j][3] * v[j][3]); }
        if (PRE) {
            const float rstd = rsqrtf(wave_sum(ss) * (1.f / D) + EPS); ss = 0.f;
            f32x4* ho = (f32x4*)(hdst + (size_t)m * D) + lane;
#pragma unroll
            for (int j = 0; j < 4; ++j) { const f32x4 gp = ((const f32x4*)gpre)[lane + 64 * j]; v[j] = v[j] * rstd * gp; ho[64 * j] = v[j];
                ss += (v[j][0] * v[j][0] + v[j][1] * v[j][1]) + (v[j][2] * v[j][2] + v[j][3] * v[j][3]); }
        }
        if (MAIN) {
            const float rstd = rsqrtf(wave_sum(ss) * (1.f / D) + EPS);
            const int b = m >> 12;
            const f32x4* sh = (const f32x4*)(modl + (size_t)b * MODW) + lane; const f32x4* scl = (const f32x4*)(modl + (size_t)b * MODW + D) + lane;
            u32x2* o8 = (u32x2*)(xn + (size_t)m * D) + lane;
#pragma unroll
            for (int j = 0; j < 4; ++j) { const f32x4 gg = ((const f32x4*)g)[lane + 64 * j]; const f32x4 y = v[j] * rstd * gg * (scl[64 * j] + 1.f) + sh[64 * j]; v[j] = y;
                u32x2 w; w.x = pk2(y[0], y[1]); w.y = pk2(y[2], y[3]); o8[64 * j] = w; }
            if (DT) {
                float d[16];
#pragma unroll
                for (int hh = 0; hh < 16; ++hh) { float a = 0.f;
#pragma unroll
                    for (int j = 0; j < 4; ++j) { const f32x4 w4 = *(const f32x4*)(wl + hh * 1024 + 4 * (lane + 64 * j)); a += (v[j][0] * w4[0] + v[j][1] * w4[1]) + (v[j][2] * w4[2] + v[j][3] * w4[3]); }
                    d[hh] = a; if ((hh & 3) == 3) asm volatile("" ::: "memory"); }
                { const bool hb = (lane & 32) != 0;
#pragma unroll
                    for (int i = 0; i < 8; ++i) { const float keep = hb ? d[i + 8] : d[i], send = hb ? d[i] : d[i + 8]; d[i] = keep + __shfl_xor(send, 32); } }
                { const bool hb = (lane & 16) != 0;
#pragma unroll
                    for (int i = 0; i < 4; ++i) { const float keep = hb ? d[i + 4] : d[i], send = hb ? d[i] : d[i + 4]; d[i] = keep + __shfl_xor(send, 16); } }
                { const bool hb = (lane & 8) != 0;
#pragma unroll
                    for (int i = 0; i < 2; ++i) { const float keep = hb ? d[i + 2] : d[i], send = hb ? d[i] : d[i + 2]; d[i] = keep + __shfl_xor(send, 8); } }
                { const bool hb = (lane & 4) != 0; const float keep = hb ? d[1] : d[0], send = hb ? d[0] : d[1]; d[0] = keep + __shfl_xor(send, 4); }
                d[0] += __shfl_xor(d[0], 1); d[0] += __shfl_xor(d[0], 2);
                const int hh = ((lane >> 5) & 1) * 8 + ((lane >> 4) & 1) * 4 + ((lane >> 3) & 1) * 2 + ((lane >> 2) & 1);
                if ((lane & 3) == 0) dtraw[(size_t)m * 16 + hh] = d[0];
            }
        }
    }
}

DI void gmlp_item(int item, bf16_t* PROJ, const float* vg, const float* wsp, const float* bsp, unsigned char* lds) {
    int tid_ = threadIdx.x; asm volatile("" : "+v"(tid_));
    const int tid = tid_, lane = tid & 63, wave = tid >> 6, fr = lane & 15, fq = lane >> 4;
    const int b = item >> 8, blk = (item >> 3) & 31, g = item & 7;
    const int r0 = b * SEQ + blk * 128;
    bf16_t* vnT = (bf16_t*)lds;
    bf16_t* Wm = vnT + 128 * 136;
    {
        const int row = tid >> 2, q4 = tid & 3;
        const bf16_t* vp = PROJ + (size_t)(r0 + row) * PW + 1024 + g * 128 + q4 * 32;
        u32x4 raw[4];
#pragma unroll
        for (int i = 0; i < 4; ++i) raw[i] = *(const u32x4*)(vp + 8 * i);
        float f[32]; float ss = 0.f;
#pragma unroll
        for (int i = 0; i < 4; ++i)
#pragma unroll
            for (int e = 0; e < 4; ++e) { const unsigned u = raw[i][e]; f[8 * i + 2 * e] = bflo(u); f[8 * i + 2 * e + 1] = bfhi(u); }
#pragma unroll
        for (int i = 0; i < 32; ++i) ss += f[i] * f[i];
        ss += __shfl_xor(ss, 1); ss += __shfl_xor(ss, 2);
        const float rstd = rsqrtf(ss * (1.f / 128.f) + EPS);
        const float* gp = vg + g * 128 + q4 * 32;
#pragma unroll
        for (int i = 0; i < 32; ++i) vnT[(q4 * 32 + i) * 136 + row] = (bf16_t)f2bf(f[i] * rstd * gp[i]);
        const float* wp = wsp + ((size_t)g * 128 + row) * 128 + q4 * 32;
#pragma unroll
        for (int i = 0; i < 8; ++i) { f32x4 w4 = *(const f32x4*)(wp + 4 * i);
            if (row < 64 && q4 >= 2) w4 = (f32x4){0.f, 0.f, 0.f, 0.f};
            u32x2 o; o.x = pk2(w4[0], w4[1]); o.y = pk2(w4[2], w4[3]); *(u32x2*)(Wm + row * 136 + q4 * 32 + 4 * i) = o; }
    }
    __syncthreads();
    f32x4 acc[8];
#pragma unroll
    for (int ct = 0; ct < 8; ++ct) acc[ct] = (f32x4){0.f, 0.f, 0.f, 0.f};
    const int nks = (wave < 4) ? 2 : 4;
    for (int ks = 0; ks < nks; ++ks) {
        const bf16x8 af = *(const bf16x8*)(Wm + (16 * wave + fr) * 136 + 32 * ks + 8 * fq);
#pragma unroll
        for (int ct = 0; ct < 8; ++ct) { const bf16x8 bfr = *(const bf16x8*)(vnT + (16 * ct + fr) * 136 + 32 * ks + 8 * fq);
            acc[ct] = __builtin_amdgcn_mfma_f32_16x16x32_bf16(bfr, af, acc[ct], 0, 0, 0); }
    }
    {
        const int t = 16 * wave + fr; const float bias = bsp[g * 128 + t];
        bf16_t* up = PROJ + (size_t)(r0 + t) * PW + g * 128 + 4 * fq;
#pragma unroll
        for (int ct = 0; ct < 8; ++ct) { const u32x2 u2 = *(const u32x2*)(up + 16 * ct);
            u32x2 o; o.x = pk2(bflo(u2.x) * (acc[ct][0] + bias), bfhi(u2.x) * (acc[ct][1] + bias)); o.y = pk2(bflo(u2.y) * (acc[ct][2] + bias), bfhi(u2.y) * (acc[ct][3] + bias));
            *(u32x2*)(up + 16 * ct) = o; }
    }
    __syncthreads();
}


DI void conv_phase(const bf16_t* PROJ, bf16_t* XSC, bf16_t* BCC, const float* conv_w, const float* conv_b, int G) {
    int tid_ = threadIdx.x; asm volatile("" : "+v"(tid_));
    const int tid = tid_, cg8 = tid & 63, rb = tid >> 6;
    for (int item = blockIdx.x; item < 1536; item += G) {
        const int rblk = item / 3, third = item - rblk * 3;
        const int ch0 = third * 512 + cg8 * 8;
        const int t0 = rblk * 64 + rb * 8;
        const bool seq_start = ((t0 & (SEQ - 1)) == 0);
        const bf16_t* src = PROJ + (size_t)t0 * PW + 3072 + ch0;
        u32x4 raw[11];
#pragma unroll
        for (int i = 0; i < 11; ++i) raw[i] = (i < 3 && seq_start) ? (u32x4){0u, 0u, 0u, 0u} : *(const u32x4*)(src + (ptrdiff_t)(i - 3) * PW);
        bf16_t* dst = third < 2 ? XSC + (size_t)t0 * D + ch0 : BCC + (size_t)t0 * 512 + (ch0 - 1024);
        const int ldd = third < 2 ? D : 512;
        u32x4 o[8];
#pragma unroll
        for (int e = 0; e < 4; ++e) {
            const float* wp = conv_w + ch0 + 2 * e;
            const float w00 = wp[0], w01 = wp[1], w10 = wp[1536], w11 = wp[1537], w20 = wp[3072], w21 = wp[3073], w30 = wp[4608], w31 = wp[4609];
            const float b0 = conv_b[ch0 + 2 * e], b1 = conv_b[ch0 + 2 * e + 1];
#pragma unroll
            for (int i = 0; i < 8; ++i) {
                const unsigned u0 = raw[i][e], u1 = raw[i + 1][e], u2 = raw[i + 2][e], u3 = raw[i + 3][e];
                const float a0 = b0 + w00 * bflo(u0) + w10 * bflo(u1) + w20 * bflo(u2) + w30 * bflo(u3);
                const float a1 = b1 + w01 * bfhi(u0) + w11 * bfhi(u1) + w21 * bfhi(u2) + w31 * bfhi(u3);
                o[i][e] = pk2(silu_f(a0), silu_f(a1));
            }
        }
#pragma unroll
        for (int i = 0; i < 8; ++i) *(u32x4*)(dst + (size_t)i * ldd) = o[i];
    }
}

DI void ssd_item(int item, bf16_t* PROJ, bf16_t* ybase, int ldy, const float* dtraw, const bf16_t* XSC, const bf16_t* BCC, const float* dt_bias, const float* a_log, const float* dskip, float* rowss, unsigned char* lds) {
    int tid_ = threadIdx.x; asm volatile("" : "+v"(tid_));
    const int tid = tid_, lane = tid & 63, wave = tid >> 6, fr = lane & 15, fq = lane >> 4, r32 = lane & 31, hi = lane >> 5;
    const int b = item >> 4, hd = item & 15, g = hd >> 3;
    float* dtv = (float*)lds; float* csv = dtv + 4096;
    bf16_t* Cn = (bf16_t*)(lds + 32768);
    bf16_t* Bn = Cn + 64 * 136;
    bf16_t* BsT = Bn + 64 * 136;
    bf16_t* xsT = BsT + 128 * 72;
    bf16_t* Wl = xsT + 64 * 72;
    bf16_t* Hb = Wl + 64 * 72;
    const float Aneg = -__expf(a_log[hd]), dtb = dt_bias[hd], Dk = dskip[hd];
    for (int i = 0; i < 8; ++i) {
        const int t = (wave + 8 * i) * 64 + lane;
        const float raw = dtraw[(size_t)(b * SEQ + t) * 16 + hd] + dtb;
        const float dt = raw > 20.f ? raw : softplus_f(raw);
        float x = dt * Aneg;
#pragma unroll
        for (int o = 1; o < 64; o <<= 1) { const float y = __shfl_up(x, o); if (lane >= o) x += y; }
        dtv[t] = dt; csv[t] = x;
    }
    for (int idx = tid; idx < 64 * 136 / 2; idx += NTHREADS) ((unsigned*)Hb)[idx] = 0u;
    const bool active = tid < 320; const int cgp = tid % 40, rb = (tid / 40) & 7;
    const bf16_t* xcol = cgp < 8 ? XSC + (size_t)(b * SEQ) * D + hd * 64 + 8 * cgp
                                 : BCC + (size_t)(b * SEQ) * 512 + (cgp < 24 ? g * 128 + 8 * (cgp - 8) : 256 + g * 128 + 8 * (cgp - 24));
    const int ldx = cgp < 8 ? D : 512;
    f32x16 Hacc;
#pragma unroll
    for (int r = 0; r < 16; ++r) Hacc[r] = 0.f;
    u32x4 raw[8];
#define SSD_LOAD_RAW(c) do { _Pragma("unroll") for (int i = 0; i < 8; ++i) raw[i] = *(const u32x4*)(xcol + (size_t)((c) * 64 + rb * 8 + i) * ldx); } while (0)
    if (active) SSD_LOAD_RAW(0);
    __syncthreads();
    const int tt = wave >> 1, half = wave & 1;
    for (int c = 0; c < 64; ++c) {
        const int tb = c * 64;
        if (active) {
            float o[8][8];
#pragma unroll
            for (int i = 0; i < 8; ++i)
#pragma unroll
                for (int e = 0; e < 4; ++e) { o[i][2 * e] = bflo(raw[i][e]); o[i][2 * e + 1] = bfhi(raw[i][e]); }
            if (cgp < 8) {
#pragma unroll
                for (int cc = 0; cc < 8; ++cc) { u32x4 w; w.x = pk2(o[0][cc], o[1][cc]); w.y = pk2(o[2][cc], o[3][cc]); w.z = pk2(o[4][cc], o[5][cc]); w.w = pk2(o[6][cc], o[7][cc]);
                    *(u32x4*)(xsT + (8 * cgp + cc) * 72 + rb * 8) = w; }
            } else if (cgp < 24) {
                const int n0 = 8 * (cgp - 8);
                const float cse = csv[tb + 63];
                float dte[8];
#pragma unroll
                for (int i = 0; i < 8; ++i) { const int t = tb + rb * 8 + i; dte[i] = __expf(cse - csv[t]) * dtv[t]; }
#pragma unroll
                for (int i = 0; i < 8; ++i) *(u32x4*)(Bn + (rb * 8 + i) * 136 + n0) = raw[i];
#pragma unroll
                for (int cc = 0; cc < 8; ++cc) { u32x4 w; w.x = pk2(o[0][cc] * dte[0], o[1][cc] * dte[1]); w.y = pk2(o[2][cc] * dte[2], o[3][cc] * dte[3]);
                    w.z = pk2(o[4][cc] * dte[4], o[5][cc] * dte[5]); w.w = pk2(o[6][cc] * dte[6], o[7][cc] * dte[7]);
                    *(u32x4*)(BsT + (n0 + cc) * 72 + rb * 8) = w; }
            } else {
                const int n0 = 8 * (cgp - 24);
#pragma unroll
                for (int i = 0; i < 8; ++i) *(u32x4*)(Cn + (rb * 8 + i) * 136 + n0) = raw[i];
            }
            if (c < 63) SSD_LOAD_RAW(c + 1);
        }
        __syncthreads();
        const int trow = 16 * tt + fr;
        bf16_t* zrow = PROJ + (size_t)(b * SEQ + tb + trow) * PW + 2048 + hd * 64 + 4 * fq;
        u32x2 zr[2];
#pragma unroll
        for (int p2 = 0; p2 < 2; ++p2) zr[p2] = *(const u32x2*)(zrow + 16 * (2 * half + p2));
        const float cs_t = csv[tb + trow];
        bf16x8 cf[4];
#pragma unroll
        for (int ks = 0; ks < 4; ++ks) cf[ks] = *(const bf16x8*)(Cn + trow * 136 + 32 * ks + 8 * fq);
#pragma unroll
        for (int s2 = 0; s2 < 2; ++s2) {
            const int st = 2 * half + s2;
            u32x2 w; w.x = 0u; w.y = 0u;
            if (st <= tt) {
                f32x4 ga = (f32x4){0.f, 0.f, 0.f, 0.f};
#pragma unroll
                for (int ks = 0; ks < 4; ++ks) { const bf16x8 bfr = *(const bf16x8*)(Bn + (16 * st + fr) * 136 + 32 * ks + 8 * fq);
                    ga = __builtin_amdgcn_mfma_f32_16x16x32_bf16(bfr, cf[ks], ga, 0, 0, 0); }
                float wv[4];
#pragma unroll
                for (int j = 0; j < 4; ++j) { const int s = 16 * st + 4 * fq + j;
                    float val = (s <= trow) ? ga[j] * __expf(cs_t - csv[tb + s]) * dtv[tb + s] : 0.f;
                    if (s == trow) val += Dk;
                    wv[j] = val; }
                w.x = pk2(wv[0], wv[1]); w.y = pk2(wv[2], wv[3]);
            }
            *(u32x2*)(Wl + trow * 72 + 16 * st + 4 * fq) = w;
        }
        f32x4 ya[2];
#pragma unroll
        for (int p2 = 0; p2 < 2; ++p2) { ya[p2] = (f32x4){0.f, 0.f, 0.f, 0.f}; const int pt = 2 * half + p2;
#pragma unroll
            for (int ks = 0; ks < 4; ++ks) { const bf16x8 hf = *(const bf16x8*)(Hb + (16 * pt + fr) * 136 + 32 * ks + 8 * fq);
                ya[p2] = __builtin_amdgcn_mfma_f32_16x16x32_bf16(hf, cf[ks], ya[p2], 0, 0, 0); }
            ya[p2] = ya[p2] * __expf(cs_t); }
        __syncthreads();
        {
            const int nks = (tt < 2) ? 1 : 2;
            for (int ks = 0; ks < nks; ++ks) { const bf16x8 wf = *(const bf16x8*)(Wl + trow * 72 + 32 * ks + 8 * fq);
#pragma unroll
                for (int p2 = 0; p2 < 2; ++p2) { const bf16x8 xf = *(const bf16x8*)(xsT + (16 * (2 * half + p2) + fr) * 72 + 32 * ks + 8 * fq);
                    ya[p2] = __builtin_amdgcn_mfma_f32_16x16x32_bf16(xf, wf, ya[p2], 0, 0, 0); } }
            float ss = 0.f;
#pragma unroll
            for (int p2 = 0; p2 < 2; ++p2) { const float z0 = bflo(zr[p2].x), z1 = bfhi(zr[p2].x), z2 = bflo(zr[p2].y), z3 = bfhi(zr[p2].y);
                const float y0 = ya[p2][0] * silu_f(z0), y1 = ya[p2][1] * silu_f(z1), y2 = ya[p2][2] * silu_f(z2), y3 = ya[p2][3] * silu_f(z3);
                ss += (y0 * y0 + y1 * y1) + (y2 * y2 + y3 * y3);
                u32x2 o; o.x = pk2(y0, y1); o.y = pk2(y2, y3); *(u32x2*)(ybase + (size_t)(b * SEQ + tb + trow) * ldy + hd * 64 + 4 * fq + 16 * (2 * half + p2)) = o; }
            ss += __shfl_xor(ss, 16); ss += __shfl_xor(ss, 32);
            if (fq == 0) atomicAdd(rowss + (size_t)(b * SEQ + tb + trow), ss);
            const int pp = wave >> 2, nn = wave & 3;
            const float cd = __expf(csv[tb + 63]);
#pragma unroll
            for (int r = 0; r < 16; ++r) Hacc[r] *= cd;
#pragma unroll
            for (int ks = 0; ks < 4; ++ks) { const bf16x8 bf = *(const bf16x8*)(BsT + (32 * nn + r32) * 72 + 16 * ks + 8 * hi);
                const bf16x8 xf = *(const bf16x8*)(xsT + (32 * pp + r32) * 72 + 16 * ks + 8 * hi);
                Hacc = __builtin_amdgcn_mfma_f32_32x32x16_bf16(bf, xf, Hacc, 0, 0, 0); }
#pragma unroll
            for (int r4 = 0; r4 < 4; ++r4) { u32x2 o; o.x = pk2(Hacc[4 * r4], Hacc[4 * r4 + 1]); o.y = pk2(Hacc[4 * r4 + 2], Hacc[4 * r4 + 3]);
                *(u32x2*)(Hb + (32 * pp + r32) * 136 + 32 * nn + 8 * r4 + 4 * hi) = o; }
        }
        __syncthreads();
    }
#undef SSD_LOAD_RAW
}

DI int pi32(int m) { return (m & ~12) | ((m & 4) << 1) | ((m & 8) >> 1); }
DI void attn_phase(const bf16_t* Q, const bf16_t* Kg, const bf16_t* Vt, bf16_t* O, unsigned char* lds, int G) {
    int tid_ = threadIdx.x; asm volatile("" : "+v"(tid_));
    const int tid = tid_, lane = tid & 63, wave = tid >> 6, r32 = lane & 31, hi = lane >> 5;
    const int key = tid >> 3, ch = tid & 7, stoff = key * 144 + ch * 16;
    const int krow = pi32(r32);
    unsigned* aflag = (unsigned*)(lds + 36864);
    for (int v = blockIdx.x; v < 256; v += G) {
        const int bh = v >> 1, par = v & 1, b = bh >> 4, hd = bh & 15;
        const bf16_t* kgp = Kg + (size_t)(b * SEQ + key) * D + hd * 64 + 8 * ch;
        const bf16_t* vgp = Vt + (size_t)(hd * 64 + key) * T + b * SEQ + 8 * ch;
        for (int ui = 0; ui < 8; ++ui) {
            const int s_ = par * 4 + (ui >> 1), qb = (ui & 1) ? 15 - s_ : s_;
            const int q0 = qb * 256, qw = q0 + 32 * wave, NT = 4 * qb + 4, tq = qw >> 6;
            const bf16_t* qp = Q + (size_t)(b * SEQ + qw + r32) * D + hd * 64 + 8 * hi;
            bf16x8 qf[4];
#pragma unroll
            for (int d0 = 0; d0 < 4; ++d0) qf[d0] = *(const bf16x8*)(qp + 16 * d0);
            f32x16 o0, o1;
#pragma unroll
            for (int r = 0; r < 16; ++r) { o0[r] = 0.f; o1[r] = 0.f; }
            float run = 0.f;
            u32x4 kr = *(const u32x4*)(kgp + (size_t)(NT - 1) * 64 * D), vr = *(const u32x4*)(vgp + (NT - 1) * 64);
            *(u32x4*)(lds + stoff) = kr; *(u32x4*)(lds + 9216 + stoff) = vr;
            __syncthreads();
            int buf = 0;
            for (int i = NT - 1; i >= 0; --i, buf ^= 1) {
                if (i > 0) { kr = *(const u32x4*)(kgp + (size_t)(i - 1) * 64 * D); vr = *(const u32x4*)(vgp + (i - 1) * 64); }
                if (i <= tq) {
                    const unsigned char* Kl = lds + buf * 18432; const unsigned char* Vl = Kl + 9216;
                    f32x16 p[2];
#pragma unroll
                    for (int kb = 0; kb < 2; ++kb) {
#pragma unroll
                        for (int r = 0; r < 16; ++r) p[kb][r] = 0.f;
#pragma unroll
                        for (int d0 = 0; d0 < 4; ++d0) { const bf16x8 kf = *(const bf16x8*)(Kl + (32 * kb + krow) * 144 + (16 * d0 + 8 * hi) * 2);
                            p[kb] = __builtin_amdgcn_mfma_f32_32x32x16_bf16(kf, qf[d0], p[kb], 0, 0, 0); }
                    }
                    const bool masked = (i == tq);
                    float lk[2][16];
#pragma unroll
                    for (int kb = 0; kb < 2; ++kb)
#pragma unroll
                        for (int r = 0; r < 16; ++r) {
                            const float z = p[kb][r];
                            const float sp = fmaxf(z, 0.f) + lg2(1.f + ex2(-fabsf(z)));
                            float lkv = -sp, lb = z - sp;
                            if (masked) { const int ka = 64 * i + 32 * kb + 16 * (r >> 3) + 8 * hi + (r & 7); const bool valid = ka < qw + r32; lkv = valid ? lkv : 0.f; lb = valid ? lb : -INFINITY; }
                            lk[kb][r] = lkv; p[kb][r] = lb;
                        }
                    float glo[2][2], ghi[2][2];
#pragma unroll
                    for (int kb = 0; kb < 2; ++kb)
#pragma unroll
                        for (int s = 0; s < 2; ++s) { float gs = 0.f;
#pragma unroll
                            for (int j = 0; j < 8; ++j) gs += lk[kb][8 * s + j];
                            auto rr = __builtin_amdgcn_permlane32_swap(__float_as_uint(gs), __float_as_uint(gs), false, false);
                            glo[kb][s] = __uint_as_float(rr[0]); ghi[kb][s] = __uint_as_float(rr[1]); }
                    float basev = run;
#pragma unroll
                    for (int kb = 1; kb >= 0; --kb)
#pragma unroll
                        for (int s = 1; s >= 0; --s) {
                            float a = basev + (hi == 0 ? ghi[kb][s] : 0.f);
#pragma unroll
                            for (int j = 7; j >= 0; --j) { const float w = ex2(p[kb][8 * s + j] + a); a += lk[kb][8 * s + j]; p[kb][8 * s + j] = w; }
                            basev += glo[kb][s] + ghi[kb][s];
                        }
                    run = basev;
#pragma unroll
                    for (int kb = 0; kb < 2; ++kb)
#pragma unroll
                        for (int s = 0; s < 2; ++s) {
                            u32x4 pw; pw.x = cvt_pk_bf16(p[kb][8 * s + 0], p[kb][8 * s + 1]); pw.y = cvt_pk_bf16(p[kb][8 * s + 2], p[kb][8 * s + 3]);
                            pw.z = cvt_pk_bf16(p[kb][8 * s + 4], p[kb][8 * s + 5]); pw.w = cvt_pk_bf16(p[kb][8 * s + 6], p[kb][8 * s + 7]);
                            const bf16x8 pa = __builtin_bit_cast(bf16x8, pw);
                            const bf16x8 v0 = *(const bf16x8*)(Vl + (r32) * 144 + (32 * kb + 16 * s + 8 * hi) * 2);
                            const bf16x8 v1 = *(const bf16x8*)(Vl + (32 + r32) * 144 + (32 * kb + 16 * s + 8 * hi) * 2);
                            o0 = __builtin_amdgcn_mfma_f32_32x32x16_bf16(pa, v0, o0, 0, 0, 0);
                            o1 = __builtin_amdgcn_mfma_f32_32x32x16_bf16(pa, v1, o1, 0, 0, 0);
                        }
                }
                if (i > 0) { *(u32x4*)(lds + (buf ^ 1) * 18432 + stoff) = kr; *(u32x4*)(lds + (buf ^ 1) * 18432 + 9216 + stoff) = vr; }
                if (lane == 0) aflag[buf * 8 + wave] = __any(run > -100.f) ? 1u : 0u;
                __syncthreads();
                { const u32x4 f0 = *(const u32x4*)(aflag + buf * 8), f1 = *(const u32x4*)(aflag + buf * 8 + 4);
                  if (((f0.x | f0.y) | (f0.z | f0.w) | (f1.x | f1.y) | (f1.z | f1.w)) == 0u) break; }
            }
            bf16_t* op = O + (size_t)(b * SEQ + qw) * D + hd * 64 + r32;
#pragma unroll
            for (int r = 0; r < 16; ++r) { const int qrow = (r & 3) + 8 * (r >> 2) + 4 * hi;
                op[(size_t)qrow * D] = (bf16_t)f2bf(o0[r]); op[(size_t)qrow * D + 32] = (bf16_t)f2bf(o1[r]); }
        }
    }
}


#define XB_TMO      128
#define XB_XCNT(j)  (256  + 64 * (j))
#define XB_XSUB(j)  (1280 + 64 * (j))
#define XB_XGEN(j)  (2304 + 64 * (j))
#define XB_TOP      3328
#define XB_TOPGEN   3392
#define XCD_BAR_WORDS 3456
#define XB_SPIN_CAP (1u << 18)
DI unsigned xb_ld(unsigned* p)              { return __hip_atomic_load(p, __ATOMIC_RELAXED, __HIP_MEMORY_SCOPE_AGENT); }
DI unsigned xb_add(unsigned* p, unsigned v) { return __hip_atomic_fetch_add(p, v, __ATOMIC_RELAXED, __HIP_MEMORY_SCOPE_AGENT); }
DI unsigned xb_xcc_id() { return (unsigned)__builtin_amdgcn_s_getreg((3 << 11) | 20) & 0xFu; }
#define XB_SPIN(cond, bar) do { unsigned _sp = 0; while (cond) { __builtin_amdgcn_s_sleep(1); \
    if ((++_sp & 255u) == 0u) { if (xb_ld(&(bar)[XB_TMO])) break; if (_sp > XB_SPIN_CAP) { atomicAdd(&(bar)[XB_TMO], 1u); break; } } } } while (0)
struct XcdBarrier { unsigned* bar; unsigned x; volatile LAS unsigned* st; };
DI XcdBarrier xcd_barrier_post(unsigned* bar, volatile LAS unsigned* st) {
    XcdBarrier b; b.bar = bar; b.x = xb_xcc_id(); b.st = st;
    if (threadIdx.x == 0) (void)xb_add(&bar[XB_XCNT(b.x)], 1u);
    return b;
}
DI void xcd_barrier_complete(unsigned* bar, unsigned x, unsigned& nloc, unsigned& nx) {
    const unsigned G = gridDim.x * gridDim.y * gridDim.z;
    unsigned sum, cnt, mine, sp = 0u;
    for (;;) {
        sum = 0u; cnt = 0u; mine = 0u;
#pragma unroll
        for (unsigned j = 0; j < 16; ++j) { const unsigned c = xb_ld(&bar[XB_XCNT(j)]); sum += c; cnt += (c > 0u) ? 1u : 0u; mine = (j == x) ? c : mine; }
        if (sum == G) break;
        __builtin_amdgcn_s_sleep(1);
        if ((++sp & 255u) == 0u) { if (xb_ld(&bar[XB_TMO])) break; if (sp > XB_SPIN_CAP) { atomicAdd(&bar[XB_TMO], 1u); break; } }
    }
    nloc = mine > 0u ? mine : 1u; nx = cnt > 0u ? cnt : 1u;
}
DI void xcd_barrier(const XcdBarrier& b) {
    asm volatile("s_waitcnt vmcnt(0)" ::: "memory");
    __syncthreads();
    if (threadIdx.x == 0) {
        unsigned* bar = b.bar;
        __builtin_amdgcn_s_waitcnt(0);
        unsigned nloc = b.st[0], nx = b.st[1];
        if (nloc == 0u) { xcd_barrier_complete(bar, b.x, nloc, nx); b.st[0] = nloc; b.st[1] = nx; }
        const unsigned old = xb_add(&bar[XB_XSUB(b.x)], 1u);
        const unsigned gen = old / nloc;
        if (old + 1u == (gen + 1u) * nloc) {
            __builtin_amdgcn_fence(__ATOMIC_RELEASE, "agent");
            asm volatile("s_waitcnt vmcnt(0)" ::: "memory");
            const unsigned og = xb_add(&bar[XB_TOP], 1u);
            const unsigned tg = og / nx;
            if (og + 1u == (tg + 1u) * nx) xb_add(&bar[XB_TOPGEN], 1u);
            else XB_SPIN(xb_ld(&bar[XB_TOPGEN]) == tg, bar);
            __builtin_amdgcn_fence(__ATOMIC_ACQUIRE, "agent");
            xb_add(&bar[XB_XGEN(b.x)], 1u);
            asm volatile("s_waitcnt vmcnt(0)" ::: "memory");
        } else {
            XB_SPIN(xb_ld(&bar[XB_XGEN(b.x)]) == gen, bar);
            __builtin_amdgcn_fence(__ATOMIC_ACQUIRE, "agent");
            asm volatile("s_waitcnt vmcnt(0)" ::: "memory");
        }
    }
    __syncthreads();
}
#ifndef PM
#define PM 0xFFFF
#endif
#define PH(bit) if constexpr ((PM >> (bit)) & 1)
#ifdef USE_CG_SYNC
#define GSYNC() grid.sync()
#else
#define GSYNC() xcd_barrier(xbar)
#endif
__global__ void __launch_bounds__(NTHREADS, 2) fwd_megakernel(Params P) {
    extern __shared__ __attribute__((aligned(16))) unsigned char lds[];
    cg::grid_group grid = cg::this_grid();
    const int G = gridDim.x, bid = blockIdx.x;
    unsigned char* ws = P.ws;
    LAS unsigned char* ldsl = (LAS unsigned char*)lds;
    float* mod = (float*)(ws + WS_MOD);
    float* rowss = (float*)(ws + WS_ROWSS);
    float* dtraw = (float*)(ws + WS_DT);
    bf16_t* XN = (bf16_t*)(ws + WS_XN);
    bf16_t* BIG = (bf16_t*)(ws + WS_BIG);
    float* H = P.out;
    const float* normg = P.in[4];

    unsigned* barw = (unsigned*)(ws + WS_ROWSS + 512 * 1024);
    if (bid == 0) for (int i = threadIdx.x; i < XCD_BAR_WORDS; i += NTHREADS) barw[i] = 0u;
    volatile LAS unsigned* xst = (volatile LAS unsigned*)(ldsl + 147456 - 64);
    if (threadIdx.x < 2) xst[threadIdx.x] = 0u;
    PH(0) p0_phase(P, lds, G);
#ifdef REP_P0
    __syncthreads(); p0_phase(P, lds, G);
#endif
    grid.sync();
    XcdBarrier xbar = xcd_barrier_post(barw, xst);

    for (int l = 0; l < 2; ++l) {
        const float* modl = mod + (size_t)l * 8 * MODW;
        PH(1) { if (l == 0) { norm_phase<false, true, false>(P.in[0], nullptr, nullptr, XN, normg + (l * 4 + 0) * D, modl + 0 * 3072, nullptr, nullptr, lds, G);
#ifdef REP_N1
            __syncthreads(); norm_phase<false, true, false>(P.in[0], nullptr, nullptr, XN, normg + (l * 4 + 0) * D, modl + 0 * 3072, nullptr, nullptr, lds, G);
#endif
        }
        else        norm_phase<true, true, false>(H, H, normg + (0 * 4 + 3) * D, XN, normg + (l * 4 + 0) * D, modl + 0 * 3072, nullptr, nullptr, lds, G); }
        GSYNC();
        for (int i = 0; i < 2; ++i) {
            const int f = l * 2 + i;
            if (i == 1) { PH(1) norm_phase<false, true, false>(H, nullptr, nullptr, XN, normg + (l * 4 + 2) * D, modl + 2 * 3072, nullptr, nullptr, lds, G); GSYNC(); }
            PH(2) { pg8::Gemm g{XN, (const bf16_t*)(ws + WS_WGU) + (size_t)f * 5632 * 1024, T, 5632, D, D, 1 << 30, 0, nullptr}; pg8::StaticOrder S; S.init(T, 5632, G, bid);
              pg8::EpiSwiGLU E{BIG}; pg8::gemm_phase(ldsl, g, S, E); }
#ifdef REP_GU
            if (f == 0) { __syncthreads(); pg8::Gemm g{XN, (const bf16_t*)(ws + WS_WGU) + (size_t)f * 5632 * 1024, T, 5632, D, D, 1 << 30, 0, nullptr}; pg8::StaticOrder S; S.init(T, 5632, G, bid);
              pg8::EpiSwiGLU E{BIG}; pg8::gemm_phase(ldsl, g, S, E); }
#endif
            GSYNC();
            PH(3) { pg8::Gemm g{BIG, (const bf16_t*)(ws + WS_WDN) + (size_t)f * D * FF, T, D, FF, FF, 1 << 30, 0, nullptr}; pg8::StaticOrder S; S.init(T, D, G, bid);
              pg8::EpiResid<1, false> E{(l == 0 && i == 0) ? P.in[0] : H, H, modl + (i == 0 ? 0 : 2) * 3072 + 2048, rowss}; pg8::gemm_phase(ldsl, g, S, E); }
            GSYNC();
            if (i == 0) {
                if (l == 0) {
                    PH(1) norm_phase<false, true, true>(H, nullptr, nullptr, XN, normg + (l * 4 + 1) * D, modl + 1 * 3072, dtraw, P.in[8], lds, G);
                    GSYNC();
                    PH(4) { pg8::Gemm g{XN, (const bf16_t*)(ws + WS_WIN), T, PW, D, D, 1 << 30, 0, nullptr}; pg8::StaticOrder S; S.init(T, PW, G, bid);
                      pg8::EpiProj E{BIG}; pg8::gemm_phase(ldsl, g, S, E); }
                    GSYNC();
                    conv_phase(BIG, XN, (bf16_t*)(ws + WS_BCC), P.in[13], P.in[14], G);
                    GSYNC();
                    if (G >= 256) {
                        if (bid < 128) { PH(5) ssd_item(bid, BIG, BIG + 2048, PW, dtraw, XN, (const bf16_t*)(ws + WS_BCC), P.in[15], P.in[16], P.in[17], rowss, lds); }
                        else { PH(6) for (int it = bid - 128; it < 2048; it += G - 128) gmlp_item(it, BIG, P.in[10], P.in[11], P.in[12], lds); }
                    } else {
                        PH(5) for (int it = bid; it < 128; it += G) { ssd_item(it, BIG, BIG + 2048, PW, dtraw, XN, (const bf16_t*)(ws + WS_BCC), P.in[15], P.in[16], P.in[17], rowss, lds); __syncthreads(); }
                        PH(6) for (int it = bid; it < 2048; it += G) gmlp_item(it, BIG, P.in[10], P.in[11], P.in[12], lds);
                    }
                    GSYNC();
                    PH(7) { pg8::Gemm g{BIG + 2048, (const bf16_t*)(ws + WS_WOUT1), T, D, 2 * D, PW, 16, -6144, rowss}; pg8::StaticOrder S; S.init(T, D, G, bid);
                      pg8::EpiResid<2, false> E{H, H, modl + 1 * 3072 + 2048, rowss}; pg8::gemm_phase(ldsl, g, S, E); }
                    GSYNC();
                } else {
                    PH(1) norm_phase<false, true, false>(H, nullptr, nullptr, XN, normg + (l * 4 + 1) * D, modl + 1 * 3072, nullptr, nullptr, lds, G);
                    GSYNC();
                    PH(8) { pg8::Gemm g{XN, (const bf16_t*)(ws + WS_WQK), T, 2 * D, D, D, 1 << 30, 0, nullptr}; pg8::StaticOrder S; S.init(T, 2 * D, G, bid);
                      pg8::EpiQK E{(bf16_t*)(ws + WS_Q), (bf16_t*)(ws + WS_K), P.in[20], P.in[21], 0.125f * LOG2E}; pg8::gemm_phase(ldsl, g, S, E); }
                    PH(8) { pg8::Gemm g{(const bf16_t*)(ws + WS_WV), XN, D, T, D, D, 1 << 30, 0, nullptr}; pg8::StaticOrder S; S.init(D, T, G, bid);
                      pg8::EpiPlain E{(bf16_t*)(ws + WS_VT), T}; pg8::gemm_phase(ldsl, g, S, E); }
                    GSYNC();
                    PH(9) attn_phase((const bf16_t*)(ws + WS_Q), (const bf16_t*)(ws + WS_K), (const bf16_t*)(ws + WS_VT), XN, lds, G);
#ifdef REP_ATT
                    __syncthreads(); attn_phase((const bf16_t*)(ws + WS_Q), (const bf16_t*)(ws + WS_K), (const bf16_t*)(ws + WS_VT), XN, lds, G);
#endif
                    GSYNC();
                    PH(10) { pg8::Gemm g{XN, (const bf16_t*)(ws + WS_WO), T, D, D, D, 1 << 30, 0, nullptr}; pg8::StaticOrder S; S.init(T, D, G, bid);
                      pg8::EpiResid<2, false> E{H, H, modl + 1 * 3072 + 2048, rowss}; pg8::gemm_phase(ldsl, g, S, E); }
                    GSYNC();
                }
            }
        }
    }
#ifdef REP_SYNC
    for (int r = 0; r < 20; ++r) grid.sync();
#endif
    PH(1) norm_phase<true, false, false>(H, H, normg + (1 * 4 + 3) * D, nullptr, nullptr, nullptr, nullptr, nullptr, lds, G);
}

extern "C" void kernel_launch(void* const* d_in, const int* in_sizes, int n_in, void* d_out, int out_size, void* d_ws, size_t ws_size, hipStream_t stream) {
    static int grid = 0;
    if (grid == 0) {
        if (n_in != 23 || out_size != T * D || ws_size < WS_END) { fprintf(stderr, "kernel_launch: unexpected shapes (n_in %d out %d ws %zu)\n", n_in, out_size, ws_size); grid = -1; return; }
        int dev = 0, cus = 0, per_cu = 0;
        hipGetDevice(&dev);
        hipDeviceGetAttribute(&cus, hipDeviceAttributeMultiprocessorCount, dev);
        hipFuncSetAttribute((const void*)fwd_megakernel, hipFuncAttributeMaxDynamicSharedMemorySize, LDS_BYTES);
        hipOccupancyMaxActiveBlocksPerMultiprocessor(&per_cu, (const void*)fwd_megakernel, NTHREADS, LDS_BYTES);
        if (per_cu < 1) per_cu = 1;
        grid = cus * per_cu;
        (void)hipGetLastError();
    }
    if (grid < 0) return;
    Params p{};
    for (int i = 0; i < 23; ++i) p.in[i] = (const float*)d_in[i];
    p.out = (float*)d_out; p.ws = (unsigned char*)d_ws;
    void* args[] = {&p};
    hipError_t e = hipLaunchCooperativeKernel((const void*)fwd_megakernel, dim3(grid), dim3(NTHREADS), args, LDS_BYTES, stream);
    if (e != hipSuccess) fprintf(stderr, "cooperative launch failed: %s (grid %d)\n", hipGetErrorString(e), grid);
}
```
